# Optimizing an MI355X kernel written in HIP

```python
import math
import jax
import jax.numpy as jnp
from jax import lax
import numpy as np

D_MODEL = 1024
BATCH = 16
SEQ = 256
DEPTH = 4
DEC_BATCH = 8
DEC_SEQ = 1024
PAST_LEN = 256

GRID_W = 64
N_MIXERS = 4
N_DA = (DEPTH + 3) // 4
N_NA = (DEPTH + 2) // 4
N_GQ = (DEPTH + 1) // 4
N_HY = DEPTH // 4
Q_BLOCK = 128
D_FF = 4 * D_MODEL
DA_DH = 64
DA_HEADS = D_MODEL // (2 * DA_DH)
NA_DH = 64
NA_HEADS = D_MODEL // NA_DH
NA_WIN_ROWS = 8
NA_WIN_COLS = 16
GQ_DH = 64
GQ_HEADS = D_MODEL // GQ_DH
GQ_KV_HEADS = 4
GQ_GROUP = GQ_HEADS // GQ_KV_HEADS
HY_ORDER = 2
HY_SHORT = 3
HY_BANDS = 16
HY_EMB = 1 + 2 * HY_BANDS
HY_FFN = 64
HY_DECAY_MIN = 3.07
HY_DECAY_MAX = 15.35
ROPE_BASE = 10000.0
LN_EPS = 1e-5
RMS_EPS = 1e-6
DN_ALPHA = (2 * DEPTH) ** 0.25
DN_BETA = (8 * DEPTH) ** -0.25
NEG_INF = -1e30

kernel_name = "hybrid_diffusion_trunk_step"


def layer_norm(x, g, b):
    xf = x.astype(jnp.float32)
    mu = jnp.mean(xf, axis=-1, keepdims=True)
    var = jnp.mean(jnp.square(xf - mu), axis=-1, keepdims=True)
    return ((xf - mu) * lax.rsqrt(var + LN_EPS) * g + b).astype(x.dtype)


def rms_norm(x, g):
    xf = x.astype(jnp.float32)
    return (xf * lax.rsqrt(jnp.mean(xf * xf, axis=-1, keepdims=True) + RMS_EPS) * g).astype(x.dtype)


def softmax_f32(s):
    return jax.nn.softmax(s.astype(jnp.float32), axis=-1)


def modulate(x, shift, scale):
    return x * (1.0 + scale) + shift


def axial_rope(x):
    L, dh = x.shape[1], x.shape[-1]
    n = dh // 4
    pos = jnp.arange(L)
    inv = ROPE_BASE ** (-jnp.arange(n, dtype=jnp.float32) / n)
    shp = (L,) + (1,) * (x.ndim - 3) + (n,)
    ang_r = ((pos // GRID_W).astype(jnp.float32)[:, None] * inv).reshape(shp)
    ang_c = ((pos % GRID_W).astype(jnp.float32)[:, None] * inv).reshape(shp)
    cr, sr, cc, sc = jnp.cos(ang_r), jnp.sin(ang_r), jnp.cos(ang_c), jnp.sin(ang_c)
    xr1, xr2, xc1, xc2 = jnp.split(x, 4, axis=-1)
    out = jnp.concatenate([xr1 * cr - xr2 * sr, xr1 * sr + xr2 * cr,
                           xc1 * cc - xc2 * sc, xc1 * sc + xc2 * cc], axis=-1)
    return out.astype(x.dtype)


def sweep_query_blocks(fn, q):
    B, L = q.shape[:2]
    nb = L // Q_BLOCK
    qb = jnp.moveaxis(q.reshape((B, nb, Q_BLOCK) + q.shape[2:]), 1, 0)
    ob = lax.map(fn, qb)
    return jnp.moveaxis(ob, 0, 1).reshape((B, L) + ob.shape[3:])


def mha_block(qb, k, v, scale):
    p = softmax_f32(jnp.einsum("bqhd,bkhd->bhqk", qb, k) * scale).astype(v.dtype)
    return jnp.einsum("bhqk,bkhd->bqhd", p, v)


def diff_attention(h_ctx, h_lat, cache_k, cache_v, w_qkv, w_o, lam_p, subln_g, layer_idx):
    lam_init = 0.8 - 0.6 * math.exp(-0.3 * layer_idx)
    lam = (jnp.exp(jnp.sum(lam_p[0] * lam_p[1]).astype(jnp.float32))
           - jnp.exp(jnp.sum(lam_p[2] * lam_p[3]).astype(jnp.float32)) + lam_init)
    scale = DA_DH ** -0.5

    def project(h):
        B, L, _ = h.shape
        q, k, v = jnp.split(h @ w_qkv, 3, axis=-1)
        shp = (B, L, DA_HEADS, 2 * DA_DH)
        return q.reshape(shp), k.reshape(shp), v.reshape(shp)

    def attend(k, v):
        k1, k2 = jnp.split(k, 2, axis=-1)

        def block(qb):
            q1, q2 = jnp.split(qb, 2, axis=-1)
            p1 = softmax_f32(jnp.einsum("bqhd,bkhd->bhqk", q1, k1) * scale)
            p2 = softmax_f32(jnp.einsum("bqhd,bkhd->bhqk", q2, k2) * scale)
            return jnp.einsum("bhqk,bkhd->bqhd", (p1 - lam * p2).astype(v.dtype), v)
        return block

    def finish(o):
        B, L = o.shape[:2]
        o = rms_norm(o, subln_g) * (1.0 - lam_init)
        return o.reshape(B, L, DA_HEADS * 2 * DA_DH) @ w_o

    def rope_pair(x):
        B, L = x.shape[:2]
        return axial_rope(x.reshape(B, L, DA_HEADS, 2, DA_DH)).reshape(x.shape)

    qc, kc, vc = project(h_ctx)
    out_ctx = finish(sweep_query_blocks(attend(kc, vc), qc))
    ql, kl, vl = project(h_lat)
    ql, kl = rope_pair(ql), rope_pair(kl)
    k_all = jnp.concatenate([kl, cache_k], axis=1)
    v_all = jnp.concatenate([vl, cache_v], axis=1)
    out_lat = finish(sweep_query_blocks(attend(k_all, v_all), ql))
    return out_ctx, out_lat, kc, vc


def neighbourhood_attention(h_ctx, h_lat, cache_k, cache_v, w_qkv, w_o, rel_bias):
    scale = NA_DH ** -0.5

    def project(h):
        B, L, _ = h.shape
        q, k, v = jnp.split(h @ w_qkv, 3, axis=-1)
        shp = (B, L, NA_HEADS, NA_DH)
        return q.reshape(shp), k.reshape(shp), v.reshape(shp)

    qc, kc, vc = project(h_ctx)
    Bc, Lc = h_ctx.shape[:2]
    oc = sweep_query_blocks(lambda qb: mha_block(qb, kc, vc, scale), qc)
    out_ctx = oc.reshape(Bc, Lc, NA_HEADS * NA_DH) @ w_o

    ql, kl, vl = project(h_lat)
    B, L = h_lat.shape[:2]
    rows = L // GRID_W
    kr = min(NA_WIN_ROWS, rows)
    grid = (B, rows, GRID_W, NA_HEADS, NA_DH)
    qg, kg, vg = ql.reshape(grid), kl.reshape(grid), vl.reshape(grid)
    row_start = jnp.clip(jnp.arange(rows) - kr // 2, 0, rows - kr)
    cols = jnp.arange(GRID_W)
    col_start = jnp.clip(cols - NA_WIN_COLS // 2, 0, GRID_W - NA_WIN_COLS)
    col_in = ((cols[None, :] >= col_start[:, None])
              & (cols[None, :] < col_start[:, None] + NA_WIN_COLS))
    rel_c = jnp.clip(cols[None, :] - cols[:, None], -(NA_WIN_COLS - 1), NA_WIN_COLS - 1) + NA_WIN_COLS - 1

    def row_block(r):
        rs = row_start[r]
        q_r = lax.dynamic_index_in_dim(qg, r, axis=1, keepdims=False)
        k_r = lax.dynamic_slice_in_dim(kg, rs, kr, axis=1)
        v_r = lax.dynamic_slice_in_dim(vg, rs, kr, axis=1)
        rel_r = rs + jnp.arange(kr) - r + NA_WIN_ROWS - 1
        bias = rel_bias[:, rel_r[None, :, None], rel_c[:, None, :]]
        s_loc = jnp.einsum("bqhd,bikhd->bhqik", q_r, k_r).astype(jnp.float32) * scale + bias
        s_loc = jnp.where(col_in[:, None, :], s_loc, NEG_INF).reshape(B, NA_HEADS, GRID_W, kr * GRID_W)
        s_ctx = jnp.einsum("bqhd,bshd->bhqs", q_r, cache_k).astype(jnp.float32) * scale
        p = jax.nn.softmax(jnp.concatenate([s_loc, s_ctx], axis=-1), axis=-1).astype(v_r.dtype)
        p_loc = p[..., :kr * GRID_W].reshape(B, NA_HEADS, GRID_W, kr, GRID_W)
        p_ctx = p[..., kr * GRID_W:]
        return (jnp.einsum("bhqik,bikhd->bqhd", p_loc, v_r)
                + jnp.einsum("bhqs,bshd->bqhd", p_ctx, cache_v))

    ol = lax.map(row_block, jnp.arange(rows))
    out_lat = jnp.moveaxis(ol, 0, 1).reshape(B, L, NA_HEADS * NA_DH) @ w_o
    return out_ctx, out_lat, kc, vc


def gq_attention(h_ctx, h_lat, cache_k, cache_v, w_qkv, w_o, q_norm, k_norm):
    scale = GQ_DH ** -0.5
    nq, nk = GQ_HEADS * GQ_DH, GQ_KV_HEADS * GQ_DH

    def project(h):
        B, L, _ = h.shape
        u = h @ w_qkv
        q = rms_norm(u[..., :nq].reshape(B, L, GQ_HEADS, GQ_DH), q_norm)
        k = rms_norm(u[..., nq:nq + nk].reshape(B, L, GQ_KV_HEADS, GQ_DH), k_norm)
        v = u[..., nq + nk:].reshape(B, L, GQ_KV_HEADS, GQ_DH)
        return q, k, v

    def attend(k, v):
        def block(qb):
            B, Q = qb.shape[:2]
            qg = qb.reshape(B, Q, GQ_KV_HEADS, GQ_GROUP, GQ_DH)
            p = softmax_f32(jnp.einsum("bqkgd,bskd->bkgqs", qg, k) * scale).astype(v.dtype)
            return jnp.einsum("bkgqs,bskd->bqkgd", p, v).reshape(B, Q, nq)
        return block

    qc, kc, vc = project(h_ctx)
    out_ctx = sweep_query_blocks(attend(kc, vc), qc) @ w_o
    ql, kl, vl = project(h_lat)
    ql, kl = axial_rope(ql), axial_rope(kl)
    k_all = jnp.concatenate([kl, cache_k], axis=1)
    v_all = jnp.concatenate([vl, cache_v], axis=1)
    out_lat = sweep_query_blocks(attend(k_all, v_all), ql) @ w_o
    return out_ctx, out_lat, kc, vc


def hyena_filters_fft(L, w1, b1, w2, b2, freq, w3, log_decay):
    t = jnp.arange(L, dtype=jnp.float32) / L
    ang = 2.0 * math.pi * t[:, None] * jnp.arange(1, HY_BANDS + 1, dtype=jnp.float32)
    emb = jnp.concatenate([t[:, None], jnp.cos(ang), jnp.sin(ang)], axis=-1)
    hid = jnp.sin(freq * (emb @ w1 + b1))
    hid = jnp.sin(freq * (hid @ w2 + b2))
    window = jnp.exp(-jnp.exp(log_decay.astype(jnp.float32)) * t[:, None])
    filt = ((hid @ w3).astype(jnp.float32) * window).reshape(L, HY_ORDER, 2, D_MODEL)
    fwd, bwd = filt[:, :, 0], filt[:, :, 1]
    two_sided = jnp.concatenate(
        [fwd, jnp.zeros((1, HY_ORDER, D_MODEL), jnp.float32), bwd[:0:-1]], axis=0)
    return jnp.fft.rfft(two_sided, axis=0)


def long_conv(z, freq_resp):
    L = z.shape[1]
    zf = jnp.fft.rfft(z.astype(jnp.float32), n=2 * L, axis=1)
    return jnp.fft.irfft(zf * freq_resp[None], n=2 * L, axis=1)[:, :L].astype(z.dtype)


def centred_short_conv(u, w, b):
    L = u.shape[1]
    up = jnp.pad(u, ((0, 0), (HY_SHORT // 2, HY_SHORT // 2), (0, 0)))
    return up[:, :L] * w[0] + up[:, 1:L + 1] * w[1] + up[:, 2:L + 2] * w[2] + b


def hyena(h, w_in, short_w, short_b, w1, b1, w2, b2, freq, w3, log_decay, filter_bias, w_o):
    L = h.shape[1]
    freq_resp = hyena_filters_fft(L, w1, b1, w2, b2, freq, w3, log_decay)
    parts = jnp.split(centred_short_conv(h @ w_in, short_w, short_b), HY_ORDER + 1, axis=-1)
    z = parts[0]
    for o in range(HY_ORDER):
        z = parts[o + 1] * (long_conv(z, freq_resp[:, o]) + z * filter_bias[o])
    return z @ w_o


def squared_relu_mlp(h, w1, w2):
    return jnp.square(jax.nn.relu(h @ w1)) @ w2


def setup_inputs(seed: int = 0) -> dict:
    key = jax.random.key(seed)
    ks = iter(jax.random.split(key, 64))
    d = D_MODEL

    def nrm(shape, scale):
        return jax.random.normal(next(ks), shape, jnp.float32) * scale

    da_w = DA_HEADS * 2 * DA_DH
    na_w = NA_HEADS * NA_DH
    gq_qkv = (GQ_HEADS + 2 * GQ_KV_HEADS) * GQ_DH
    n_filt = 2 * HY_ORDER * d
    return {
        "x_prompt": nrm((BATCH, SEQ, d), 1.0),
        "x_sample": nrm((DEC_BATCH, DEC_SEQ, d), 1.0),
        "c": nrm((DEC_BATCH, d), 1.0),
        "cache_da_k": nrm((DEC_BATCH, N_DA, PAST_LEN, DA_HEADS, 2 * DA_DH), 1.0),
        "cache_da_v": nrm((DEC_BATCH, N_DA, PAST_LEN, DA_HEADS, 2 * DA_DH), 1.0),
        "cache_na_k": nrm((DEC_BATCH, N_NA, PAST_LEN, NA_HEADS, NA_DH), 1.0),
        "cache_na_v": nrm((DEC_BATCH, N_NA, PAST_LEN, NA_HEADS, NA_DH), 1.0),
        "cache_gq_k": nrm((DEC_BATCH, N_GQ, PAST_LEN, GQ_KV_HEADS, GQ_DH), 1.0),
        "cache_gq_v": nrm((DEC_BATCH, N_GQ, PAST_LEN, GQ_KV_HEADS, GQ_DH), 1.0),
        "c_ctx": nrm((d,), 1.0),
        "ada_w": nrm((DEPTH, d, 6 * d), 0.02),
        "ada_b": nrm((DEPTH, 6 * d), 0.02),
        "ln_g": 1.0 + nrm((DEPTH, 2, d), 0.02),
        "ln_b": nrm((DEPTH, 2, d), 0.02),
        "mlp_w1": nrm((DEPTH, d, D_FF), d ** -0.5),
        "mlp_w2": nrm((DEPTH, D_FF, d), DN_BETA * D_FF ** -0.5),
        "da_w_qkv": nrm((N_DA, d, 3 * da_w), d ** -0.5),
        "da_w_o": nrm((N_DA, da_w, d), DN_BETA * da_w ** -0.5),
        "da_lambda": nrm((N_DA, 4, DA_DH), 0.1),
        "da_subln_g": 1.0 + nrm((N_DA, 2 * DA_DH), 0.02),
        "na_w_qkv": nrm((N_NA, d, 3 * na_w), d ** -0.5),
        "na_w_o": nrm((N_NA, na_w, d), DN_BETA * na_w ** -0.5),
        "na_rel_bias": nrm((N_NA, NA_HEADS, 2 * NA_WIN_ROWS - 1, 2 * NA_WIN_COLS - 1), 0.1),
        "gq_w_qkv": nrm((N_GQ, d, gq_qkv), d ** -0.5),
        "gq_w_o": nrm((N_GQ, GQ_HEADS * GQ_DH, d), DN_BETA * (GQ_HEADS * GQ_DH) ** -0.5),
        "gq_q_norm": 1.0 + nrm((N_GQ, GQ_DH), 0.02),
        "gq_k_norm": 1.0 + nrm((N_GQ, GQ_DH), 0.02),
        "hy_w_in": nrm((N_HY, d, (HY_ORDER + 1) * d), d ** -0.5),
        "hy_short_w": nrm((N_HY, HY_SHORT, (HY_ORDER + 1) * d), 0.5),
        "hy_short_b": nrm((N_HY, (HY_ORDER + 1) * d), 0.02),
        "hy_ffn_w1": nrm((N_HY, HY_EMB, HY_FFN), HY_EMB ** -0.5),
        "hy_ffn_b1": nrm((N_HY, HY_FFN), 0.02),
        "hy_ffn_w2": nrm((N_HY, HY_FFN, HY_FFN), HY_FFN ** -0.5),
        "hy_ffn_b2": nrm((N_HY, HY_FFN), 0.02),
        "hy_ffn_freq": 1.0 + nrm((N_HY, HY_FFN), 0.02),
        "hy_ffn_w3": nrm((N_HY, HY_FFN, n_filt), 0.1 * HY_FFN ** -0.5),
        "hy_log_decay": jnp.log(jnp.linspace(HY_DECAY_MIN, HY_DECAY_MAX, n_filt))[None, :]
                        + nrm((N_HY, n_filt), 0.01),
        "hy_filter_bias": nrm((N_HY, HY_ORDER, d), 0.1),
        "hy_w_o": nrm((N_HY, d, d), DN_BETA * d ** -0.5),
    }


def reference(x_prompt, x_sample, c, cache_da_k, cache_da_v, cache_na_k, cache_na_v,
              cache_gq_k, cache_gq_v, c_ctx, ada_w, ada_b, ln_g, ln_b, mlp_w1, mlp_w2,
              da_w_qkv, da_w_o, da_lambda, da_subln_g, na_w_qkv, na_w_o, na_rel_bias,
              gq_w_qkv, gq_w_o, gq_q_norm, gq_k_norm, hy_w_in, hy_short_w, hy_short_b,
              hy_ffn_w1, hy_ffn_b1, hy_ffn_w2, hy_ffn_b2, hy_ffn_freq, hy_ffn_w3,
              hy_log_decay, hy_filter_bias, hy_w_o):
    xp, xs = x_prompt, x_sample
    silu_ctx = jax.nn.silu(c_ctx)[None, :]
    silu_c = jax.nn.silu(c)
    da_k, da_v, na_k, na_v, gq_k, gq_v = [], [], [], [], [], []
    for i in range(DEPTH):
        m, j = i % N_MIXERS, i // N_MIXERS
        mod_p = jnp.split((silu_ctx @ ada_w[i] + ada_b[i])[:, None, :], 6, axis=-1)
        mod_s = jnp.split((silu_c @ ada_w[i] + ada_b[i])[:, None, :], 6, axis=-1)
        hp = modulate(xp, mod_p[0], mod_p[1])
        hs = modulate(xs, mod_s[0], mod_s[1])
        if m == 0:
            op, os_, kc, vc = diff_attention(hp, hs, cache_da_k[:, j], cache_da_v[:, j],
                                             da_w_qkv[j], da_w_o[j], da_lambda[j], da_subln_g[j], i)
            da_k.append(kc)
            da_v.append(vc)
        elif m == 1:
            op, os_, kc, vc = neighbourhood_attention(hp, hs, cache_na_k[:, j], cache_na_v[:, j],
                                                      na_w_qkv[j], na_w_o[j], na_rel_bias[j])
            na_k.append(kc)
            na_v.append(vc)
        elif m == 2:
            op, os_, kc, vc = gq_attention(hp, hs, cache_gq_k[:, j], cache_gq_v[:, j],
                                           gq_w_qkv[j], gq_w_o[j], gq_q_norm[j], gq_k_norm[j])
            gq_k.append(kc)
            gq_v.append(vc)
        else:
            hy_args = (hy_w_in[j], hy_short_w[j], hy_short_b[j], hy_ffn_w1[j], hy_ffn_b1[j],
                       hy_ffn_w2[j], hy_ffn_b2[j], hy_ffn_freq[j], hy_ffn_w3[j],
                       hy_log_decay[j], hy_filter_bias[j], hy_w_o[j])
            op = hyena(hp, *hy_args)
            os_ = hyena(hs, *hy_args)
        xp = layer_norm(DN_ALPHA * xp + mod_p[2] * op, ln_g[i, 0], ln_b[i, 0])
        xs = layer_norm(DN_ALPHA * xs + mod_s[2] * os_, ln_g[i, 0], ln_b[i, 0])
        fp = squared_relu_mlp(modulate(xp, mod_p[3], mod_p[4]), mlp_w1[i], mlp_w2[i])
        fs = squared_relu_mlp(modulate(xs, mod_s[3], mod_s[4]), mlp_w1[i], mlp_w2[i])
        xp = layer_norm(DN_ALPHA * xp + mod_p[5] * fp, ln_g[i, 1], ln_b[i, 1])
        xs = layer_norm(DN_ALPHA * xs + mod_s[5] * fs, ln_g[i, 1], ln_b[i, 1])
    state_da_k = jnp.stack(da_k, axis=1)
    state_da_v = jnp.stack(da_v, axis=1)
    state_na_k = jnp.stack(na_k, axis=1)
    state_na_v = jnp.stack(na_v, axis=1)
    state_gq_k = jnp.stack(gq_k, axis=1)
    state_gq_v = jnp.stack(gq_v, axis=1)
    return (xp, xs, state_da_k, state_da_v, state_na_k, state_na_v, state_gq_k, state_gq_v)
```

```cpp
#include <hip/hip_runtime.h>
#include <hip/hip_cooperative_groups.h>
#include <cstdio>
#include <cstdint>
namespace cg = cooperative_groups;
__device__ __forceinline__ int tid_opaque() { int t = threadIdx.x; asm volatile("" : "+v"(t)); return t; }
namespace pg8 {
#define PG8_LAS __attribute__((address_space(3)))
typedef unsigned short bf16_t;
typedef short bf16x8 __attribute__((ext_vector_type(8)));
typedef float f32x4 __attribute__((ext_vector_type(4)));
typedef unsigned u32x4 __attribute__((ext_vector_type(4)));
constexpr int BM = 256, BK = 64, HALF = 128, HTB = HALF * BK * 2  , STAGE_BYTES = 8 * HTB, NXCD = 8, WGM = 8;

__host__ __device__ __forceinline__ int lds_byte(int r, int c) { const int st = (r >> 4) * 2 + (c >> 5), rr = r & 15, cc = c & 31, ob = rr * 64 + cc * 2; return st * 1024 + (ob ^ (((ob >> 9) & 1) << 5)); }
__host__ __device__ __forceinline__ void stage_rc(int b, int& R, int& C) { const int st = b / 1024, sb = b % 1024, swz = sb ^ (((sb >> 9) & 1) << 5); R = (st >> 1) * 16 + swz / 64; C = (st & 1) * 32 + (swz % 64) / 2; }
__host__ __device__ __forceinline__ int perm32(int rho) { const int n = rho >> 4, i = rho & 15; return 8 * (i >> 2) + 4 * n + (i & 3); }

struct Unit { int pm, pn; };
struct Gemm { const bf16_t* A; const bf16_t* Bt; int M, N, K; };

struct StaticOrder {
    int nM, nN, nwg, G, c;
    __host__ __device__ void init(int M, int N, int G_, int c_) { nM = M / BM; nN = N / BM; nwg = nM * nN; G = G_; c = c_; }
    __host__ __device__ bool next(int i, Unit& u) const {
        const long L = (long)i * G + c; if (L >= nwg) return false;
        int wgid = (int)L; { const int q = nwg / NXCD, r = nwg % NXCD, xcd = wgid % NXCD, off = wgid / NXCD; wgid = (xcd < r ? xcd * (q + 1) : r * (q + 1) + (xcd - r) * q) + off; }
        const int nig = WGM * nN, gid = wgid / nig, fm = gid * WGM, gsz = (nM - fm) < WGM ? (nM - fm) : WGM;
        u.pm = fm + ((wgid % nig) % gsz); u.pn = (wgid % nig) / gsz; return true;
    }
    __device__ __forceinline__ void a_ready(const Unit&) const {}
    __device__ __forceinline__ void done(const Unit&) const {}
};

template <class Epi, class Sched, bool ALIGN_EPI = false, bool SP2 = false>
__device__ __forceinline__ void gemm_phase(PG8_LAS unsigned char* lds, const Gemm g, const Sched& S, const Epi& E) {
    const int tid = tid_opaque(), wid = __builtin_amdgcn_readfirstlane(tid >> 6), lane = tid & 63, wr = wid >> 2, wc = wid & 3, fr = lane & 15, fq = lane >> 4;
    const int K = g.K, nt = K / BK;
    unsigned voffA[2], voffB[2];
#pragma unroll
    for (int i = 0; i < 2; ++i) { int R, C; stage_rc(tid * 16 + i * 8192, R, C); const int Rb = Epi::PERM ? ((R & ~31) + perm32(R & 31)) : R;
        voffA[i] = (unsigned)(R * K + C) * 2u; voffB[i] = (unsigned)(Rb * K + C) * 2u; }
    const size_t kstep = (size_t)(BK * 2);
    const size_t hstep = (size_t)HALF * K * 2;
    const size_t tstep = 2 * hstep;
    const unsigned ldsw = (unsigned)wid * 1024u;
    const int aoff = lds_byte(wr * 64 + fr, fq * 8), boff = lds_byte(wc * 32 + fr, fq * 8);
#define PG8_SA(b, h) (((b) * 2 + (h)) * HTB)
#define PG8_SB(b, h) ((4 + (b) * 2 + (h)) * HTB)
#define PG8_STAGE(bufoff, gbase, voff) do { _Pragma("unroll") for (int _i = 0; _i < 2; ++_i) \
        __builtin_amdgcn_global_load_lds((const unsigned*)((const char*)(gbase) + (voff)[_i]), (PG8_LAS unsigned*)(lds + (bufoff) + ldsw + _i * 8192), 16, 0, 0); } while (0)
#define PG8_LDA(dst, b, h) do { _Pragma("unroll") for (int m = 0; m < 4; ++m) _Pragma("unroll") for (int k = 0; k < 2; ++k) dst[m][k] = *(const PG8_LAS bf16x8*)(lds + PG8_SA(b, h) + aoff + m * 2048 + k * 1024); } while (0)
#define PG8_LDB(dst, b, h) do { _Pragma("unroll") for (int n = 0; n < 2; ++n) _Pragma("unroll") for (int k = 0; k < 2; ++k) dst[n][k] = *(const PG8_LAS bf16x8*)(lds + PG8_SB(b, h) + boff + n * 2048 + k * 1024); } while (0)
#define PG8_MMA(ai, bj, At, Bt) do { __builtin_amdgcn_s_setprio(1); _Pragma("unroll") for (int m = 0; m < 4; ++m) _Pragma("unroll") for (int n = 0; n < 2; ++n) _Pragma("unroll") for (int k = 0; k < 2; ++k) \
        acc[ai][bj][m][n] = __builtin_amdgcn_mfma_f32_16x16x32_bf16(Bt[n][k], At[m][k], acc[ai][bj][m][n], 0, 0, 0); __builtin_amdgcn_s_setprio(0); } while (0)
#define PG8_WAIT_V(n) asm volatile("s_waitcnt vmcnt(" #n ")" ::: "memory")
#define PG8_WAIT_L(n) asm volatile("s_waitcnt lgkmcnt(" #n ")" ::: "memory")
#define PG8_BAR __builtin_amdgcn_s_barrier()
#define PG8_SCHED __builtin_amdgcn_sched_barrier(0)
    Unit cur, nxt; int ui = 0;
    if (!S.next(0, cur)) return;
    f32x4 acc[2][2][4][2];
#pragma unroll
    for (int a = 0; a < 2; ++a)
#pragma unroll
        for (int b = 0; b < 2; ++b)
#pragma unroll
            for (int m = 0; m < 4; ++m)
#pragma unroll
                for (int n = 0; n < 2; ++n) acc[a][b][m][n] = (f32x4){0.f, 0.f, 0.f, 0.f};
    bf16x8 At[4][2], B0[2][2], B1[2][2];
    const char* cA = (const char*)g.A + (size_t)cur.pm * tstep; const char* cB = (const char*)g.Bt + (size_t)cur.pn * tstep;
    S.a_ready(cur);
    if constexpr (SP2) {
        PG8_STAGE(PG8_SB(0, 0), cB, voffB); PG8_STAGE(PG8_SB(0, 1), cB + hstep, voffB); PG8_STAGE(PG8_SA(0, 0), cA, voffA); PG8_STAGE(PG8_SA(0, 1), cA + hstep, voffA);
        if (wr == 1) PG8_BAR;
        PG8_WAIT_V(2); PG8_BAR;
        PG8_STAGE(PG8_SB(1, 0), cB + kstep, voffB); PG8_STAGE(PG8_SA(1, 0), cA + kstep, voffA); PG8_STAGE(PG8_SB(1, 1), cB + hstep + kstep, voffB);
        PG8_WAIT_V(6); PG8_BAR;
    } else {
        PG8_STAGE(PG8_SB(0, 0), cB, voffB); PG8_STAGE(PG8_SA(0, 0), cA, voffA); PG8_STAGE(PG8_SB(0, 1), cB + hstep, voffB); PG8_STAGE(PG8_SA(0, 1), cA + hstep, voffA);
        if (wr == 1) PG8_BAR;
        PG8_WAIT_V(4); PG8_BAR;
        PG8_STAGE(PG8_SB(1, 0), cB + kstep, voffB); PG8_STAGE(PG8_SA(1, 0), cA + kstep, voffA); PG8_STAGE(PG8_SB(1, 1), cB + hstep + kstep, voffB);
        PG8_WAIT_V(6); PG8_BAR;
    }
    for (;;) {
        const bool has_next = S.next(ui + 1, nxt);
        const char* nA = has_next ? (const char*)g.A + (size_t)nxt.pm * tstep : cA; const char* nB = has_next ? (const char*)g.Bt + (size_t)nxt.pn * tstep : cB;
        for (int t = 0; t < nt; t += 2) {
            const bool last = (t == nt - 2);
            const char* a1 = cA + (size_t)(t + 1) * kstep;
            const char* a2 = last ? nA : cA + (size_t)(t + 2) * kstep; const char* b2 = last ? nB : cB + (size_t)(t + 2) * kstep;
            const char* a3 = a2 + kstep; const char* b3 = b2 + kstep;
            if (last && has_next) S.a_ready(nxt);
            if constexpr (SP2) {
            PG8_LDB(B0, 0, 0); PG8_LDB(B1, 0, 1); PG8_SCHED; PG8_LDA(At, 0, 0); PG8_STAGE(PG8_SA(1, 1), a1 + hstep, voffA);
            PG8_WAIT_V(8); PG8_WAIT_L(0); PG8_BAR; PG8_MMA(0, 0, At, B0); PG8_MMA(0, 1, At, B1); PG8_BAR; PG8_SCHED;
            PG8_LDA(At, 0, 1); PG8_STAGE(PG8_SB(0, 0), b2, voffB); PG8_STAGE(PG8_SB(0, 1), b2 + hstep, voffB); PG8_STAGE(PG8_SA(0, 0), a2, voffA);
            PG8_WAIT_V(8); PG8_WAIT_L(0); PG8_BAR; PG8_MMA(1, 0, At, B0); PG8_MMA(1, 1, At, B1); PG8_BAR; PG8_SCHED;
            PG8_LDB(B0, 1, 0); PG8_LDB(B1, 1, 1); PG8_SCHED; PG8_LDA(At, 1, 0); PG8_STAGE(PG8_SA(0, 1), a2 + hstep, voffA);
            PG8_WAIT_V(8); PG8_WAIT_L(0); PG8_BAR; PG8_MMA(0, 0, At, B0); PG8_MMA(0, 1, At, B1); PG8_BAR; PG8_SCHED;
            PG8_LDA(At, 1, 1); PG8_STAGE(PG8_SB(1, 0), b3, voffB); PG8_STAGE(PG8_SB(1, 1), b3 + hstep, voffB); PG8_STAGE(PG8_SA(1, 0), a3, voffA);
            PG8_WAIT_V(8); PG8_WAIT_L(0); PG8_BAR; PG8_MMA(1, 0, At, B0); PG8_MMA(1, 1, At, B1); PG8_BAR; PG8_SCHED;
            } else {
            PG8_LDB(B0, 0, 0); PG8_SCHED; PG8_LDA(At, 0, 0); PG8_STAGE(PG8_SA(1, 1), a1 + hstep, voffA);
            PG8_WAIT_L(8); PG8_BAR; PG8_WAIT_L(0); PG8_MMA(0, 0, At, B0); PG8_BAR; PG8_SCHED;
            PG8_LDB(B1, 0, 1); PG8_STAGE(PG8_SB(0, 0), b2, voffB);
            PG8_BAR; PG8_WAIT_L(0); PG8_MMA(0, 1, At, B1); PG8_BAR;
            PG8_LDA(At, 0, 1); PG8_STAGE(PG8_SA(0, 0), a2, voffA);
            PG8_BAR; PG8_WAIT_L(0); PG8_MMA(1, 0, At, B0); PG8_BAR; PG8_SCHED;
            PG8_STAGE(PG8_SB(0, 1), b2 + hstep, voffB);
            PG8_WAIT_V(6); PG8_BAR; PG8_MMA(1, 1, At, B1); PG8_BAR;
            PG8_LDB(B0, 1, 0); PG8_SCHED; PG8_LDA(At, 1, 0); PG8_STAGE(PG8_SA(0, 1), a2 + hstep, voffA);
            PG8_WAIT_L(8); PG8_BAR; PG8_WAIT_L(0); PG8_MMA(0, 0, At, B0); PG8_BAR; PG8_SCHED;
            PG8_LDB(B1, 1, 1); PG8_STAGE(PG8_SB(1, 0), b3, voffB);
            PG8_BAR; PG8_WAIT_L(0); PG8_MMA(0, 1, At, B1); PG8_BAR;
            PG8_LDA(At, 1, 1); PG8_STAGE(PG8_SA(1, 0), a3, voffA);
            PG8_BAR; PG8_WAIT_L(0); PG8_MMA(1, 0, At, B0); PG8_BAR; PG8_SCHED;
            PG8_STAGE(PG8_SB(1, 1), b3 + hstep, voffB);
            PG8_WAIT_V(6); PG8_BAR; PG8_MMA(1, 1, At, B1); PG8_BAR;
            }
        }
        if constexpr (ALIGN_EPI) { if (wr == 0) PG8_BAR; }
        if constexpr (!Epi::AFTER_DRAIN) { E(acc, cur, wr, wc, fr, fq); S.done(cur); }
        if (!has_next) break;
#pragma unroll
        for (int a = 0; a < 2; ++a)
#pragma unroll
            for (int b = 0; b < 2; ++b)
#pragma unroll
                for (int m = 0; m < 4; ++m)
#pragma unroll
                    for (int n = 0; n < 2; ++n) acc[a][b][m][n] = (f32x4){0.f, 0.f, 0.f, 0.f};
        cur = nxt; cA = nA; cB = nB; ++ui;
        if constexpr (ALIGN_EPI) { if (wr == 1) PG8_BAR; }
    }
    PG8_WAIT_V(0);
    if constexpr (!ALIGN_EPI) { if (wr == 0) PG8_BAR; }
    PG8_BAR;
    if constexpr (Epi::AFTER_DRAIN) { E.fused(acc, cur, wr, wc, fr, fq, lds, wid, lane); S.done(cur); }
#undef PG8_SA
#undef PG8_SB
#undef PG8_STAGE
#undef PG8_LDA
#undef PG8_LDB
#undef PG8_MMA
#undef PG8_WAIT_V
#undef PG8_WAIT_L
#undef PG8_BAR
#undef PG8_SCHED
}
}
typedef unsigned short bf16_t;
typedef short bf16x8 __attribute__((ext_vector_type(8)));
typedef short s16x4 __attribute__((ext_vector_type(4)));
typedef float f32x4 __attribute__((ext_vector_type(4)));
typedef float f32x2 __attribute__((ext_vector_type(2)));
typedef float f32x16 __attribute__((ext_vector_type(16)));
typedef unsigned u32x4 __attribute__((ext_vector_type(4)));
typedef unsigned u32x2 __attribute__((ext_vector_type(2)));
typedef __bf16 bf16x2_t __attribute__((ext_vector_type(2)));
#define LAS __attribute__((address_space(3)))
constexpr int NT = 512;
constexpr int D = 1024, R = 12288, RC = 4096, FFD = 4096;
constexpr int LDS_BYTES = 147456;
constexpr size_t MiB = 1u << 20;
constexpr size_t WS_WQKV0 = 0, WS_WQKV1 = 6, WS_WQKV2 = 12, WS_WQKV3 = 15, WS_WO = 21  , WS_W1 = 29  , WS_W2 = 61  ;
constexpr size_t WS_MOD = 93, WS_H = 94, WS_QKV = 118, WS_AO = 190, WS_FF = 118;
constexpr size_t WS_CTL = 242;
constexpr size_t WS_CKDA = 214, WS_CVDA = 218, WS_CKNA = 222, WS_CVNA = 226, WS_CKGQ = 230, WS_CVGQ = 231, WS_GP1 = 232, WS_GP0 = 240, WS_END = 243;
constexpr size_t OUT_DAK = 12582912, OUT_DAV = 16777216, OUT_NAK = 20971520, OUT_NAV = 25165824, OUT_GQK = 29360128, OUT_GQV = 30408704, OUT_END = 31457280;
constexpr float DN_ALPHA = 1.681792830507429f;
constexpr float LOG2E = 1.4426950408889634f;

struct Params { const float* in[39]; float* out; unsigned char* ws; int ph_lo, ph_hi; };

__device__ __forceinline__ unsigned cvtpk(float lo, float hi) { f32x2 v = {lo, hi}; bf16x2_t b = __builtin_convertvector(v, bf16x2_t); return __builtin_bit_cast(unsigned, b); }
__device__ __forceinline__ float bf2f(unsigned short x) { return __uint_as_float(((unsigned)x) << 16); }
__device__ __forceinline__ float bflo(unsigned w) { return __uint_as_float(w << 16); }
__device__ __forceinline__ float bfhi(unsigned w) { return __uint_as_float(w & 0xffff0000u); }
__device__ __forceinline__ float wave_sum(float v) {
#pragma unroll
    for (int o = 1; o < 64; o <<= 1) v += __shfl_xor(v, o);
    return v;
}
__device__ __forceinline__ bf16_t* wsb(unsigned char* ws, size_t mib) { return (bf16_t*)(ws + mib * MiB); }
__device__ __forceinline__ int crow(int r, int hi) { return (r & 3) + 8 * (r >> 2) + 4 * hi; }

struct EpiQKV {
    static constexpr bool PERM = true, AFTER_DRAIN = false;
    bf16_t* O; int ldc; float* st_k; float* st_v; int kt0, vt0, st_ld;
    __device__ __forceinline__ void operator()(const f32x4 (&acc)[2][2][4][2], const pg8::Unit& u, int wr, int wc, int fr, int fq) const {
        const int row0 = u.pm * 256 + wr * 64 + fr, col0 = u.pn * 256 + wc * 32 + 8 * fq;
        float* st = nullptr; int scol0 = 0;
        if (u.pm < 16) {
            if (st_v && u.pn >= vt0) { st = st_v; scol0 = col0 - vt0 * 256; }
            else if (st_k && u.pn >= kt0 && u.pn < vt0) { st = st_k; scol0 = col0 - kt0 * 256; }
        }
#pragma unroll
        for (int ai = 0; ai < 2; ++ai)
#pragma unroll
            for (int m = 0; m < 4; ++m) {
                const int row = row0 + ai * 128 + m * 16;
                bf16_t* rowp = O + (size_t)row * ldc + col0;
#pragma unroll
                for (int bj = 0; bj < 2; ++bj) {
                    const f32x4 v0 = acc[ai][bj][m][0], v1 = acc[ai][bj][m][1];
                    u32x4 w; w.x = cvtpk(v0[0], v0[1]); w.y = cvtpk(v0[2], v0[3]); w.z = cvtpk(v1[0], v1[1]); w.w = cvtpk(v1[2], v1[3]);
                    *(u32x4*)(rowp + bj * 128) = w;
                    if (st) { float* sp = st + (size_t)row * st_ld + scol0 + bj * 128; *(f32x4*)sp = v0; *(f32x4*)(sp + 4) = v1; }
                }
            }
    }
};
struct EpiRelu2 {
    static constexpr bool PERM = true, AFTER_DRAIN = false;
    bf16_t* O; int ldc;
    __device__ __forceinline__ void operator()(const f32x4 (&acc)[2][2][4][2], const pg8::Unit& u, int wr, int wc, int fr, int fq) const {
        const int row0 = u.pm * 256 + wr * 64 + fr, col0 = u.pn * 256 + wc * 32 + 8 * fq;
#pragma unroll
        for (int ai = 0; ai < 2; ++ai)
#pragma unroll
            for (int m = 0; m < 4; ++m) {
                bf16_t* rowp = O + (size_t)(row0 + ai * 128 + m * 16) * ldc + col0;
#pragma unroll
                for (int bj = 0; bj < 2; ++bj) {
                    f32x4 v0 = acc[ai][bj][m][0], v1 = acc[ai][bj][m][1];
#pragma unroll
                    for (int i = 0; i < 4; ++i) { float a = fmaxf(v0[i], 0.f), b = fmaxf(v1[i], 0.f); v0[i] = a * a; v1[i] = b * b; }
                    u32x4 w; w.x = cvtpk(v0[0], v0[1]); w.y = cvtpk(v0[2], v0[3]); w.z = cvtpk(v1[0], v1[1]); w.w = cvtpk(v1[2], v1[3]);
                    *(u32x4*)(rowp + bj * 128) = w;
                }
            }
    }
};
struct EpiRes {
    static constexpr bool PERM = false, AFTER_DRAIN = false;
    float* X; const float* gate0;
    __device__ __forceinline__ void operator()(const f32x4 (&acc)[2][2][4][2], const pg8::Unit& u, int wr, int wc, int fr, int fq) const {
        const int row0 = u.pm * 256 + wr * 64 + fr, col0 = u.pn * 256 + wc * 32 + 4 * fq;
        const int j = u.pm < 16 ? 0 : 1 + ((u.pm - 16) >> 2);
        const float* g = gate0 + (size_t)j * 6144 + col0;
        f32x4 gv[2][2];
#pragma unroll
        for (int bj = 0; bj < 2; ++bj)
#pragma unroll
            for (int n = 0; n < 2; ++n) gv[bj][n] = *(const f32x4*)(g + bj * 128 + n * 16);
#pragma unroll
        for (int ai = 0; ai < 2; ++ai)
#pragma unroll
            for (int m = 0; m < 4; ++m) {
                float* rowp = X + (size_t)(row0 + ai * 128 + m * 16) * D + col0;
#pragma unroll
                for (int bj = 0; bj < 2; ++bj)
#pragma unroll
                    for (int n = 0; n < 2; ++n) {
                        float* p = rowp + bj * 128 + n * 16;
                        const f32x4 x = *(const f32x4*)p;
                        *(f32x4*)p = x * DN_ALPHA + gv[bj][n] * acc[ai][bj][m][n];
                    }
            }
    }
};
__device__ __forceinline__ void transpose_item(const float* W, int K, int N, bf16_t* WT, LAS float* scr, int item, int lane) {
    const int nblk = N / 32, kb = item / nblk, nb = item % nblk, k0 = 64 * kb, n0 = 32 * nb;
#pragma unroll 8
    for (int i = 0; i < 32; ++i) { const int kk = 2 * i + (lane >> 5); scr[kk * 33 + (lane & 31)] = W[(size_t)(k0 + kk) * N + n0 + (lane & 31)]; }
    asm volatile("s_waitcnt lgkmcnt(0)" ::: "memory");
    const int c = lane & 7;
#pragma unroll
    for (int j = 0; j < 4; ++j) { const int n = (lane >> 3) + 8 * j; const LAS float* s = scr + (8 * c) * 33 + n;
        u32x4 o; o.x = cvtpk(s[0 * 33], s[1 * 33]); o.y = cvtpk(s[2 * 33], s[3 * 33]); o.z = cvtpk(s[4 * 33], s[5 * 33]); o.w = cvtpk(s[6 * 33], s[7 * 33]);
        *(u32x4*)(WT + (size_t)(n0 + n) * K + k0 + 8 * c) = o; }
    asm volatile("s_waitcnt lgkmcnt(0)" ::: "memory");
}
__device__ __forceinline__ void cvt_range(const float* src, bf16_t* dst, int n, int gtid, int gthreads) {
    for (int i = gtid * 4; i < n; i += gthreads * 4) { const f32x4 v = *(const f32x4*)(src + i); u32x2 w; w.x = cvtpk(v[0], v[1]); w.y = cvtpk(v[2], v[3]); *(u32x2*)(dst + i) = w; }
}
__device__ __forceinline__ float silu_f(float x) { return x / (1.f + expf(-x)); }

__device__ __forceinline__ void transpose_layer(const Params& P, int l, LAS float* scr, int gw, int ngw, int lane) {
    unsigned char* ws = P.ws;
    const int NQ = l == 2 ? 1536 : 3072;
    const int IQ = 16 * (NQ / 32), IO = 16 * 32, IW1 = 16 * 128, IW2 = 64 * 32;
    const float* wq = l == 0 ? P.in[16] : l == 1 ? P.in[20] : l == 2 ? P.in[23] : P.in[27];
    const float* wo = l == 0 ? P.in[17] : l == 1 ? P.in[21] : l == 2 ? P.in[24] : P.in[38];
    bf16_t* tq = l == 0 ? wsb(ws, WS_WQKV0) : l == 1 ? wsb(ws, WS_WQKV1) : l == 2 ? wsb(ws, WS_WQKV2) : wsb(ws, WS_WQKV3);
    for (int it = gw; it < IQ + IO + IW1 + IW2; it += ngw) {
        int r = it;
        if (r < IQ) { transpose_item(wq, 1024, NQ, tq, scr, r, lane); continue; } r -= IQ;
        if (r < IO) { transpose_item(wo, 1024, 1024, wsb(ws, WS_WO + 2 * l), scr, r, lane); continue; } r -= IO;
        if (r < IW1) { transpose_item(P.in[14] + (size_t)l * 1024 * 4096, 1024, 4096, wsb(ws, WS_W1 + 8 * l), scr, r, lane); continue; } r -= IW1;
        transpose_item(P.in[15] + (size_t)l * 4096 * 1024, 4096, 1024, wsb(ws, WS_W2 + 8 * l), scr, r, lane);
    }
}

__device__ __forceinline__ void prologue(const Params& P, LAS unsigned char* lds) {
    const int tid = tid_opaque(), lane = tid & 63, wave = tid >> 6, G = gridDim.x, bid = blockIdx.x;
    unsigned char* ws = P.ws;
    {
        LAS float* sv = (LAS float*)lds;
        LAS float* red = (LAS float*)(lds + 36864);
        for (int i = tid; i < 9 * 1024; i += NT) { const int j = i >> 10, k = i & 1023; const float x = j == 0 ? P.in[9][k] : P.in[2][(j - 1) * 1024 + k]; sv[i] = silu_f(x); }
        __syncthreads();
        float* mod = (float*)(ws + WS_MOD * MiB);
        for (int item = bid; item < 4 * 96; item += G) {
            const int l = item / 96, n0 = (item % 96) * 64, ks = tid >> 5, ln = tid & 31;
            const float* W = P.in[10] + (size_t)l * 1024 * 6144 + n0 + 2 * ln;
            float a0[9], a1[9];
#pragma unroll
            for (int j = 0; j < 9; ++j) { a0[j] = 0.f; a1[j] = 0.f; }
#pragma unroll 4
            for (int kk = 0; kk < 64; ++kk) {
                const int k = ks * 64 + kk; const f32x2 w = *(const f32x2*)(W + (size_t)k * 6144);
#pragma unroll
                for (int j = 0; j < 9; ++j) { const float s = sv[j * 1024 + k]; a0[j] += s * w.x; a1[j] += s * w.y; }
            }
#pragma unroll
            for (int j = 0; j < 9; ++j) { red[(ks * 9 + j) * 64 + 2 * ln] = a0[j]; red[(ks * 9 + j) * 64 + 2 * ln + 1] = a1[j]; }
            __syncthreads();
            for (int idx = tid; idx < 576; idx += NT) { const int j = idx >> 6, n = idx & 63; float s = P.in[11][l * 6144 + n0 + n];
#pragma unroll
                for (int q = 0; q < 16; ++q) s += red[(q * 9 + j) * 64 + n];
                mod[(size_t)(l * 9 + j) * 6144 + n0 + n] = s; }
            __syncthreads();
        }
    }
    {
        LAS float* emb = (LAS float*)lds;
        LAS float* h1T = (LAS float*)(lds + 8448);
        LAS float* h2T = (LAS float*)(lds + 8448 + 16384);
        const float* w1 = P.in[30]; const float* b1 = P.in[31]; const float* w2 = P.in[32]; const float* b2 = P.in[33]; const float* fq = P.in[34]; const float* w3 = P.in[35]; const float* ld = P.in[36];
        for (int item = bid; item < 20 * 64; item += G) {
            const int pc = item >> 6, cc = item & 63;
            const int L = pc < 16 ? 1024 : 256, p0 = (pc < 16 ? pc : pc - 16) * 64;
            bf16_t* GP = pc < 16 ? wsb(ws, WS_GP1) : wsb(ws, WS_GP0);
            for (int i = tid; i < 64 * 33; i += NT) { const int pos = i / 33, e = i % 33; const int ti = p0 + pos; float v;
                if (e == 0) v = (float)ti / (float)L;
                else { const int band = e <= 16 ? e : e - 16; const int ph = (ti * band) & (L - 1); const float a = 6.283185307179586f * ((float)ph / (float)L); v = e <= 16 ? cosf(a) : sinf(a); }
                emb[pos * 33 + e] = v; }
            __syncthreads();
            const int pos = lane;
            {
                float sa[8];
#pragma unroll
                for (int kk = 0; kk < 8; ++kk) sa[kk] = b1[wave * 8 + kk];
#pragma unroll 1
                for (int e = 0; e < 33; ++e) { const float ev = emb[pos * 33 + e]; const float* wp = w1 + e * 64 + wave * 8;
#pragma unroll
                    for (int kk = 0; kk < 8; ++kk) sa[kk] += ev * wp[kk]; }
#pragma unroll
                for (int kk = 0; kk < 8; ++kk) h1T[(wave * 8 + kk) * 64 + pos] = sinf(fq[wave * 8 + kk] * sa[kk]);
            }
            __syncthreads();
            {
                float sa[8];
#pragma unroll
                for (int kk = 0; kk < 8; ++kk) sa[kk] = b2[wave * 8 + kk];
#pragma unroll 1
                for (int j = 0; j < 64; ++j) { const float hv = h1T[j * 64 + pos]; const float* wp = w2 + j * 64 + wave * 8;
#pragma unroll
                    for (int kk = 0; kk < 8; ++kk) sa[kk] += hv * wp[kk]; }
#pragma unroll
                for (int kk = 0; kk < 8; ++kk) h2T[(wave * 8 + kk) * 64 + pos] = sinf(fq[wave * 8 + kk] * sa[kk]);
            }
            __syncthreads();
            float acc[8];
#pragma unroll
            for (int c = 0; c < 8; ++c) acc[c] = 0.f;
            const int col0 = cc * 64 + wave * 8;
#pragma unroll 1
            for (int k = 0; k < 64; ++k) { const float hv = h2T[k * 64 + pos]; const float* wr = w3 + (size_t)k * 4096 + col0;
#pragma unroll
                for (int c = 0; c < 8; ++c) acc[c] += hv * wr[c]; }
            const int ti = p0 + pos; const float t = (float)ti / (float)L;
#pragma unroll
            for (int c = 0; c < 8; ++c) { const int col = col0 + c; const int o = col >> 11, dir = (col >> 10) & 1, d = col & 1023;
                const float val = acc[c] * expf(-expf(ld[col]) * t);
                bf16_t* g = GP + ((size_t)(o * 1024 + d)) * (2 * L);
                unsigned short bv = (unsigned short)(cvtpk(val, 0.f) & 0xffffu);
                if (dir == 0) g[L - ti] = bv; else { if (ti > 0) g[L + ti] = bv; else g[0] = 0; } }
            __syncthreads();
        }
    }
    {
        const int gtid = bid * NT + tid, gth = G * NT;
        cvt_range(P.in[3], wsb(ws, WS_CKDA), 8 * 256 * 1024, gtid, gth); cvt_range(P.in[4], wsb(ws, WS_CVDA), 8 * 256 * 1024, gtid, gth);
        cvt_range(P.in[5], wsb(ws, WS_CKNA), 8 * 256 * 1024, gtid, gth); cvt_range(P.in[6], wsb(ws, WS_CVNA), 8 * 256 * 1024, gtid, gth);
        cvt_range(P.in[7], wsb(ws, WS_CKGQ), 8 * 256 * 256, gtid, gth);  cvt_range(P.in[8], wsb(ws, WS_CVGQ), 8 * 256 * 256, gtid, gth);
    }
    transpose_layer(P, 0, (LAS float*)(lds + wave * 8448), bid * 8 + wave, G * 8, lane);
}

__device__ __forceinline__ void row_pass(const Params& P, int mode, const float* g, const float* bta, const float* modH, int shoff, int scoff) {
    const int tid = tid_opaque(), lane = tid & 63, wave = tid >> 6;
    float* X = P.out; bf16_t* H = wsb(P.ws, WS_H);
    for (int row = blockIdx.x * 8 + wave; row < R; row += gridDim.x * 8) {
        const float* src = mode == 0 ? (row < RC ? P.in[0] + (size_t)row * D : P.in[1] + (size_t)(row - RC) * D) : X + (size_t)row * D;
        f32x4 v[4];
#pragma unroll
        for (int j = 0; j < 4; ++j) v[j] = *(const f32x4*)(src + 4 * lane + 256 * j);
        if (mode == 1) {
            float s = 0.f;
#pragma unroll
            for (int j = 0; j < 4; ++j) s += (v[j][0] + v[j][1]) + (v[j][2] + v[j][3]);
            const float mean = wave_sum(s) * (1.f / D); float s2 = 0.f;
#pragma unroll
            for (int j = 0; j < 4; ++j) { v[j] = v[j] - mean; s2 += (v[j][0] * v[j][0] + v[j][1] * v[j][1]) + (v[j][2] * v[j][2] + v[j][3] * v[j][3]); }
            const float rstd = 1.f / sqrtf(wave_sum(s2) * (1.f / D) + 1e-5f);
#pragma unroll
            for (int j = 0; j < 4; ++j) { const f32x4 gg = *(const f32x4*)(g + 4 * lane + 256 * j), bb = *(const f32x4*)(bta + 4 * lane + 256 * j); v[j] = v[j] * rstd * gg + bb; }
        }
#pragma unroll
        for (int j = 0; j < 4; ++j) *(f32x4*)(X + (size_t)row * D + 4 * lane + 256 * j) = v[j];
        if (modH) {
            const int jm = row < RC ? 0 : 1 + ((row - RC) >> 10);
            const float* m = modH + (size_t)jm * 6144;
#pragma unroll
            for (int j = 0; j < 4; ++j) { const int c = 4 * lane + 256 * j; const f32x4 sh = *(const f32x4*)(m + shoff + c), sc = *(const f32x4*)(m + scoff + c);
                const f32x4 h = v[j] * (sc + 1.0f) + sh; u32x2 w; w.x = cvtpk(h[0], h[1]); w.y = cvtpk(h[2], h[3]); *(u32x2*)(H + (size_t)row * D + c) = w; }
        }
    }
}

__device__ __forceinline__ void qkfix(const Params& P, bf16_t* base, int ld, int ngroups, const float* qn, const float* kn, float* st_k, int row_lo) {
    const int tid = tid_opaque(), lane = tid & 63, wave = tid >> 6;
    const int i = lane & 15, part = (lane >> 4) & 1, gpar = lane >> 5;
    const float inv = exp2f(-(float)i * (13.287712379549449f / 16.f));
    for (int row = row_lo + blockIdx.x * 8 + wave; row < R; row += gridDim.x * 8) {
        const bool lat = row >= RC; float cs = 1.f, sn = 0.f;
        if (lat) { const int t = (row - RC) & 1023; const int pos = part ? (t & 63) : (t >> 6); const float a = (float)pos * inv; cs = cosf(a); sn = sinf(a); }
        bf16_t* rp = base + (size_t)row * ld;
        for (int k = 0; k < ngroups / 2; ++k) {
            const int gI = 2 * k + gpar; const int c1 = gI * 64 + part * 32 + i, c2 = c1 + 16;
            float x1 = bf2f(rp[c1]), x2 = bf2f(rp[c2]);
            if (qn) {
                float ss = x1 * x1 + x2 * x2;
#pragma unroll
                for (int o = 1; o < 32; o <<= 1) ss += __shfl_xor(ss, o);
                const float rstd = 1.f / sqrtf(ss * (1.f / 64.f) + 1e-6f);
                const float* w = gI < 16 ? qn : kn;
                x1 = x1 * rstd * w[part * 32 + i]; x2 = x2 * rstd * w[part * 32 + i + 16];
            }
            if (lat) { const float y1 = x1 * cs - x2 * sn, y2 = x1 * sn + x2 * cs; x1 = y1; x2 = y2; }
            rp[c1] = (unsigned short)(cvtpk(x1, 0.f) & 0xffffu); rp[c2] = (unsigned short)(cvtpk(x2, 0.f) & 0xffffu);
            if (st_k && !lat && gI >= 16) { float* sp = st_k + (size_t)row * 256 + (gI - 16) * 64 + part * 32 + i; sp[0] = x1; sp[16] = x2; }
        }
    }
}
struct KVSeg { const bf16_t* k; const bf16_t* v; int ldk, ldv, n; };
typedef short v4i16_t __attribute__((ext_vector_type(4)));
__device__ __forceinline__ s16x4 vtr(const LAS unsigned char* p) { return __builtin_bit_cast(s16x4, __builtin_amdgcn_ds_read_tr16_b64_v4i16((LAS v4i16_t*)p)); }
constexpr int AT_BTAB = 65536;
constexpr int AT_PARK = 73728;
__device__ __forceinline__ void glds16(const void* gsrc, unsigned lds_dst) { unsigned keep;
    asm volatile("s_mov_b32 %0, m0\n\ts_mov_b32 m0, %2\n\ts_nop 0\n\tglobal_load_lds_dwordx4 %1, off\n\ts_mov_b32 m0, %0" : "=&s"(keep) : "v"(gsrc), "s"(lds_dst) : "memory"); }

template <int DV, int MODE>
__device__ __forceinline__ void attn_run(LAS unsigned char* lds, const bf16_t* Qw, int ldq, const KVSeg s0, const KVSeg s1,
                                         int krow_lo, int rq, int cq, f32x16 (&o)[DV / 32], float& ltot) {
    constexpr int NS = DV == 128 ? 3 : 4, KBY = 8192, VBY = 64 * DV * 2, SLOT = KBY + VBY, RB = DV * 2;
    const int tid = tid_opaque(), lane = tid & 63, r32 = lane & 31, hi = lane >> 5;
    const int wave = __builtin_amdgcn_readfirstlane(tid >> 6);
    const unsigned lds0 = (unsigned)(uintptr_t)lds;
    const int ntile = (s0.n + s1.n) >> 6;
    const int krow = 8 * wave + (lane >> 3), kchunk = (lane & 7) ^ (lane >> 3);
    auto issue = [&](int t) {
        int kb = t * 64; const bf16_t* kp; const bf16_t* vp; int ldk, ldv;
        if (kb < s0.n) { kp = s0.k; vp = s0.v; ldk = s0.ldk; ldv = s0.ldv; } else { kb -= s0.n; kp = s1.k; vp = s1.v; ldk = s1.ldk; ldv = s1.ldv; }
        const unsigned sl = lds0 + (unsigned)((t % NS) * SLOT);
        glds16(kp + (size_t)(kb + krow) * ldk + kchunk * 8, (unsigned)__builtin_amdgcn_readfirstlane(sl + wave * 1024));
        if (DV == 64) glds16(vp + (size_t)(kb + krow) * ldv + kchunk * 8, (unsigned)__builtin_amdgcn_readfirstlane(sl + KBY + wave * 1024));
        else {
#pragma unroll
            for (int i = 0; i < 2; ++i) { const int piece = 2 * wave + i, vrow = 4 * piece + (lane >> 4), vch = (lane & 15) ^ (vrow & 7);
                glds16(vp + (size_t)(kb + vrow) * ldv + vch * 8, (unsigned)__builtin_amdgcn_readfirstlane(sl + KBY + piece * 1024)); }
        }
    };
    constexpr int IPT = DV == 128 ? 3 : 2;
#define AT_WAITBAR(tn, last) do { if ((last) - (tn) >= NS - 2) { if (IPT * (NS - 2) == 4) asm volatile("s_waitcnt vmcnt(4) lgkmcnt(0)\n\ts_barrier" ::: "memory"); else asm volatile("s_waitcnt vmcnt(3) lgkmcnt(0)\n\ts_barrier" ::: "memory"); } \
        else asm volatile("s_waitcnt vmcnt(0) lgkmcnt(0)\n\ts_barrier" ::: "memory"); } while (0)
    static_assert(IPT * (NS - 2) == 4 || IPT * (NS - 2) == 3, "vmcnt immediates");
    const int npre = ntile < NS - 1 ? ntile : NS - 1;
    for (int t = 0; t < npre; ++t) issue(t);
    bf16x8 qf[4];
#pragma unroll
    for (int ks = 0; ks < 4; ++ks) qf[ks] = *(const bf16x8*)(Qw + (size_t)r32 * ldq + ks * 16 + hi * 8);
#pragma unroll
    for (int b = 0; b < DV / 32; ++b)
#pragma unroll
        for (int r = 0; r < 16; ++r) o[b][r] = 0.f;
    float m_run = -1e30f, lsum = 0.f;
    int koff[4];
#pragma unroll
    for (int ks = 0; ks < 4; ++ks) koff[ks] = r32 * 128 + (((2 * ks + hi) ^ (r32 & 7)) << 4);
    const int q4 = (lane & 15) >> 2, p4 = lane & 3, g1 = (lane >> 4) & 1;
    const int vlane = (4 * hi + q4) * RB + 16 * ((2 * g1 + (p4 >> 1)) ^ q4) + 8 * (p4 & 1);
    const int vb0 = KBY + vlane + 64 * hi, vb1 = KBY + vlane + 64 * (1 - hi);
    const int rs = MODE == 1 ? min(max(rq - 4, 0), 8) : 0, cs = MODE == 1 ? min(max(cq - 8, 0), 48) : 0;
    const LAS float* btab = (const LAS float*)(lds + AT_BTAB);
    const float SC = 0.125f * LOG2E;
    AT_WAITBAR(0, npre - 1);
    for (int t = 0; t < ntile; ++t) {
        if (t + NS - 1 < ntile) issue(t + NS - 1);
        bool active = true; int kr = 0;
        if (MODE == 1 && t >= 4) { kr = krow_lo + t - 4; active = (kr >= rs) && (kr < rs + 8); }
        if (active) {
            const LAS unsigned char* Sl = lds + (t % NS) * SLOT;
            f32x16 p0, p1;
#pragma unroll
            for (int r = 0; r < 16; ++r) { p0[r] = 0.f; p1[r] = 0.f; }
#pragma unroll
            for (int ks = 0; ks < 4; ++ks) {
                const bf16x8 a0 = *(const LAS bf16x8*)(Sl + koff[ks]), a1 = *(const LAS bf16x8*)(Sl + 32 * 128 + koff[ks]);
                p0 = __builtin_amdgcn_mfma_f32_32x32x16_bf16(a0, qf[ks], p0, 0, 0, 0);
                p1 = __builtin_amdgcn_mfma_f32_32x32x16_bf16(a1, qf[ks], p1, 0, 0, 0);
            }
            if (MODE == 1 && t >= 4) {
                const LAS float* brow = btab + (kr - rq + 7) * 31 + 15 - cq;
#pragma unroll
                for (int r = 0; r < 16; ++r) {
                    const int kc0 = crow(r, hi), kc1 = kc0 + 32;
                    const bool v0 = (unsigned)(kc0 - cs) < 16u, v1 = (unsigned)(kc1 - cs) < 16u;
                    const float b0 = v0 ? brow[kc0] : 0.f, b1 = v1 ? brow[kc1] : 0.f;
                    p0[r] = v0 ? (p0[r] + 8.f * b0) : -INFINITY;
                    p1[r] = v1 ? (p1[r] + 8.f * b1) : -INFINITY;
                }
            }
            float mt = fmaxf(p0[0], p1[0]);
#pragma unroll
            for (int r = 1; r < 16; ++r) mt = fmaxf(fmaxf(mt, p0[r]), p1[r]);
            mt = fmaxf(mt, __shfl_xor(mt, 32));
            const float m_new = fmaxf(m_run, mt);
            if (__any(m_new > m_run)) {
                const float alpha = __builtin_amdgcn_exp2f((m_run - m_new) * SC);
                m_run = m_new; lsum *= alpha;
#pragma unroll
                for (int b = 0; b < DV / 32; ++b)
#pragma unroll
                    for (int r = 0; r < 16; ++r) o[b][r] *= alpha;
            }
            const float nmsc = -m_run * SC;
            float ps = 0.f;
#pragma unroll
            for (int r = 0; r < 16; ++r) { p0[r] = __builtin_amdgcn_exp2f(__builtin_fmaf(p0[r], SC, nmsc)); p1[r] = __builtin_amdgcn_exp2f(__builtin_fmaf(p1[r], SC, nmsc)); ps += p0[r] + p1[r]; }
            lsum += ps;
#pragma unroll
            for (int blk = 0; blk < 2; ++blk)
#pragma unroll
                for (int s = 0; s < 2; ++s) {
                    u32x4 pw;
                    if (blk == 0) { pw.x = cvtpk(p0[8 * s + 0], p0[8 * s + 1]); pw.y = cvtpk(p0[8 * s + 2], p0[8 * s + 3]); pw.z = cvtpk(p0[8 * s + 4], p0[8 * s + 5]); pw.w = cvtpk(p0[8 * s + 6], p0[8 * s + 7]); }
                    else          { pw.x = cvtpk(p1[8 * s + 0], p1[8 * s + 1]); pw.y = cvtpk(p1[8 * s + 2], p1[8 * s + 3]); pw.z = cvtpk(p1[8 * s + 4], p1[8 * s + 5]); pw.w = cvtpk(p1[8 * s + 6], p1[8 * s + 7]); }
                    const bf16x8 pb = __builtin_bit_cast(bf16x8, pw);
#pragma unroll
                    for (int dvb = 0; dvb < DV / 32; ++dvb) {
                        const LAS unsigned char* vp_ = Sl + ((dvb & 1) ? vb1 : vb0) + 128 * (dvb >> 1) + (32 * blk + 16 * s) * RB;
                        const s16x4 lo = vtr(vp_), h8 = vtr(vp_ + 8 * RB);
                        const bf16x8 af = {lo[0], lo[1], lo[2], lo[3], h8[0], h8[1], h8[2], h8[3]};
                        o[dvb] = __builtin_amdgcn_mfma_f32_32x32x16_bf16(af, pb, o[dvb], 0, 0, 0);
                    }
                }
        }
        { const int last = (t + NS - 1 < ntile) ? t + NS - 1 : ntile - 1; AT_WAITBAR(t + 1, last); }
    }
#undef AT_WAITBAR
    ltot = lsum + __shfl_xor(lsum, 32);
}

template <int DV>
__device__ __forceinline__ void attn_store(const f32x16 (&o)[DV / 32], bf16_t* Orow  , int hi) {
#pragma unroll
    for (int dvb = 0; dvb < DV / 32; ++dvb)
#pragma unroll
        for (int g4 = 0; g4 < 4; ++g4) { u32x2 w; w.x = cvtpk(o[dvb][4 * g4 + 0], o[dvb][4 * g4 + 1]); w.y = cvtpk(o[dvb][4 * g4 + 2], o[dvb][4 * g4 + 3]);
            *(u32x2*)(Orow + 32 * dvb + 8 * g4 + 4 * hi) = w; }
}

__device__ __forceinline__ void phase_attn_da(const Params& P, LAS unsigned char* lds) {
    const int tid = tid_opaque(), lane = tid & 63, wave = __builtin_amdgcn_readfirstlane(tid >> 6), r32 = lane & 31, hi = lane >> 5;
    const bf16_t* QKV = wsb(P.ws, WS_QKV); bf16_t* AO = wsb(P.ws, WS_AO);
    const bf16_t* CK = wsb(P.ws, WS_CKDA); const bf16_t* CV = wsb(P.ws, WS_CVDA);
    const float* lp = P.in[18];
    const float lam = expf(wave_sum(lp[lane] * lp[64 + lane])) - expf(wave_sum(lp[128 + lane] * lp[192 + lane])) + 0.2f;
    const float* sg = P.in[19];
    for (int u = blockIdx.x; u < 384; u += gridDim.x) {
        int qrow0, h; KVSeg s0, s1;
        if (u < 256) { const int b = u >> 5, qb = u & 3; h = (u >> 2) & 7; qrow0 = RC + b * 1024 + qb * 256;
            s0.k = CK + (size_t)b * 256 * 1024 + h * 128; s0.v = CV + (size_t)b * 256 * 1024 + h * 128; s0.ldk = 1024; s0.ldv = 1024; s0.n = 256;
            const bf16_t* base = QKV + (size_t)(RC + b * 1024) * 3072; s1.k = base + 1024 + h * 128; s1.v = base + 2048 + h * 128; s1.ldk = 3072; s1.ldv = 3072; s1.n = 1024; }
        else { const int uc = u - 256, b = uc >> 3; h = uc & 7; qrow0 = b * 256;
            const bf16_t* base = QKV + (size_t)(b * 256) * 3072; s0.k = base + 1024 + h * 128; s0.v = base + 2048 + h * 128; s0.ldk = 3072; s0.ldv = 3072; s0.n = 256;
            s1 = s0; s1.n = 0; }
        const int qrow = qrow0 + wave * 32;
        const bf16_t* Qw = QKV + (size_t)qrow * 3072 + h * 128;
        f32x16 oa[4]; float la, lb;
        LAS unsigned* park = (LAS unsigned*)(lds + AT_PARK + wave * 8192) + lane;
        attn_run<128, 0>(lds, Qw, 3072, s0, s1, 0, 0, 0, oa, la);
        { const float ia = 1.f / la;
#pragma unroll
          for (int b = 0; b < 4; ++b)
#pragma unroll
              for (int r = 0; r < 16; r += 2) park[(b * 8 + (r >> 1)) * 64] = cvtpk(oa[b][r] * ia, oa[b][r + 1] * ia); }
        KVSeg t0 = s0, t1 = s1; t0.k += 64; t1.k += 64;
        attn_run<128, 0>(lds, Qw + 64, 3072, t0, t1, 0, 0, 0, oa, lb);
        const float ib = lam / lb; float ss = 0.f;
#pragma unroll
        for (int b = 0; b < 4; ++b)
#pragma unroll
            for (int r = 0; r < 16; r += 2) { const unsigned w = park[(b * 8 + (r >> 1)) * 64];
                oa[b][r] = bflo(w) - ib * oa[b][r]; oa[b][r + 1] = bfhi(w) - ib * oa[b][r + 1]; ss += oa[b][r] * oa[b][r] + oa[b][r + 1] * oa[b][r + 1]; }
        ss += __shfl_xor(ss, 32);
        const float rstd = 0.8f / sqrtf(ss * (1.f / 128.f) + 1e-6f);
#pragma unroll
        for (int b = 0; b < 4; ++b)
#pragma unroll
            for (int g4 = 0; g4 < 4; ++g4) { const f32x4 gv = *(const f32x4*)(sg + 32 * b + 8 * g4 + 4 * hi);
#pragma unroll
                for (int i = 0; i < 4; ++i) oa[b][4 * g4 + i] *= rstd * gv[i]; }
        attn_store<128>(oa, AO + (size_t)(qrow + r32) * D + h * 128, hi);
    }
}
__device__ __forceinline__ void phase_attn_na(const Params& P, LAS unsigned char* lds) {
    const int tid = tid_opaque(), lane = tid & 63, wave = __builtin_amdgcn_readfirstlane(tid >> 6), r32 = lane & 31, hi = lane >> 5;
    const bf16_t* QKV = wsb(P.ws, WS_QKV); bf16_t* AO = wsb(P.ws, WS_AO);
    const bf16_t* CK = wsb(P.ws, WS_CKNA); const bf16_t* CV = wsb(P.ws, WS_CVNA);
    for (int u = blockIdx.x; u < 768; u += gridDim.x) {
        f32x16 o[2]; float l; int qrow, h;
        if (u < 512) { const int b = u >> 6, qb = u & 3; h = (u >> 2) & 15; const int r0 = 4 * qb;
            const int klo = min(max(r0 - 4, 0), 8), khi = min(max(r0 - 1, 0), 8) + 7;
            KVSeg s0, s1;
            s0.k = CK + (size_t)b * 256 * 1024 + h * 64; s0.v = CV + (size_t)b * 256 * 1024 + h * 64; s0.ldk = 1024; s0.ldv = 1024; s0.n = 256;
            const bf16_t* base = QKV + (size_t)(RC + b * 1024 + klo * 64) * 3072; s1.k = base + 1024 + h * 64; s1.v = base + 2048 + h * 64; s1.ldk = 3072; s1.ldv = 3072; s1.n = (khi - klo + 1) * 64;
            LAS float* btab = (LAS float*)(lds + AT_BTAB);
            if (tid < 465) btab[tid] = P.in[22][h * 465 + tid];
            qrow = RC + b * 1024 + qb * 256 + wave * 32;
            attn_run<64, 1>(lds, QKV + (size_t)qrow * 3072 + h * 64, 3072, s0, s1, klo, r0 + (wave >> 1), 32 * (wave & 1) + r32, o, l); }
        else { const int uc = u - 512, b = uc >> 4; h = uc & 15;
            const bf16_t* base = QKV + (size_t)(b * 256) * 3072; KVSeg s0, s1; s0.k = base + 1024 + h * 64; s0.v = base + 2048 + h * 64; s0.ldk = 3072; s0.ldv = 3072; s0.n = 256; s1 = s0; s1.n = 0;
            qrow = b * 256 + wave * 32;
            attn_run<64, 0>(lds, QKV + (size_t)qrow * 3072 + h * 64, 3072, s0, s1, 0, 0, 0, o, l); }
        const float il = 1.f / l;
#pragma unroll
        for (int b = 0; b < 2; ++b)
#pragma unroll
            for (int r = 0; r < 16; ++r) o[b][r] *= il;
        attn_store<64>(o, AO + (size_t)(qrow + r32) * D + h * 64, hi);
    }
}
__device__ __forceinline__ void phase_attn_gq(const Params& P, LAS unsigned char* lds) {
    const int tid = tid_opaque(), lane = tid & 63, wave = __builtin_amdgcn_readfirstlane(tid >> 6), r32 = lane & 31, hi = lane >> 5;
    const bf16_t* QKV = wsb(P.ws, WS_QKV); bf16_t* AO = wsb(P.ws, WS_AO);
    const bf16_t* CK = wsb(P.ws, WS_CKGQ); const bf16_t* CV = wsb(P.ws, WS_CVGQ);
    for (int u = blockIdx.x; u < 768; u += gridDim.x) {
        f32x16 o[2]; float l; int qrow, h; KVSeg s0, s1;
        if (u < 512) { const int b = u >> 6, qb = u & 3; h = (u >> 2) & 15; const int kv = h >> 2;
            s0.k = CK + (size_t)b * 256 * 256 + kv * 64; s0.v = CV + (size_t)b * 256 * 256 + kv * 64; s0.ldk = 256; s0.ldv = 256; s0.n = 256;
            const bf16_t* base = QKV + (size_t)(RC + b * 1024) * 1536; s1.k = base + 1024 + kv * 64; s1.v = base + 1280 + kv * 64; s1.ldk = 1536; s1.ldv = 1536; s1.n = 1024;
            qrow = RC + b * 1024 + qb * 256 + wave * 32; }
        else { const int uc = u - 512, b = uc >> 4; h = uc & 15; const int kv = h >> 2;
            const bf16_t* base = QKV + (size_t)(b * 256) * 1536; s0.k = base + 1024 + kv * 64; s0.v = base + 1280 + kv * 64; s0.ldk = 1536; s0.ldv = 1536; s0.n = 256; s1 = s0; s1.n = 0;
            qrow = b * 256 + wave * 32; }
        attn_run<64, 0>(lds, QKV + (size_t)qrow * 1536 + h * 64, 1536, s0, s1, 0, 0, 0, o, l);
        const float il = 1.f / l;
#pragma unroll
        for (int b = 0; b < 2; ++b)
#pragma unroll
            for (int r = 0; r < 16; ++r) o[b][r] *= il;
        attn_store<64>(o, AO + (size_t)(qrow + r32) * D + h * 64, hi);
    }
}
template <int L, int NB>
__device__ __forceinline__ void hyena_unit(const Params& P, LAS unsigned char* lds, int cp, int rowbase) {
    constexpr int ZS = L + 32, CS = 2 * L + 32;
    constexpr int IMG_B = 2 * 4 * CS * 2, Z_B = 2 * NB * ZS * 2;
    constexpr int NTT = L / 16, TPW = NTT / 4, NSS = L / 32;
    LAS unsigned char* img = lds; LAS unsigned char* zb0 = lds + IMG_B; LAS unsigned char* zb1 = lds + IMG_B + Z_B;
    const int tid = tid_opaque(), lane = tid & 63, wave = __builtin_amdgcn_readfirstlane(tid >> 6);
    const bf16_t* UT = wsb(P.ws, WS_QKV); bf16_t* AO = wsb(P.ws, WS_AO);
    const bf16_t* GP = L == 1024 ? wsb(P.ws, WS_GP1) : wsb(P.ws, WS_GP0);
    const float* sw = P.in[28]; const float* sb = P.in[29]; const float* fb = P.in[37];
    for (int task = tid; task < 2 * NB * (L / 8); task += NT) {
        const int t8 = (task % (L / 8)) * 8, b = (task / (L / 8)) % NB, ch = task / ((L / 8) * NB);
        const int d = 2 * cp + ch;
        const bf16_t* up = UT + (size_t)d * R + rowbase + b * L + t8;
        const u32x4 w = *(const u32x4*)up;
        float x[10];
        x[0] = t8 > 0 ? bf2f(up[-1]) : 0.f; x[9] = t8 + 8 < L ? bf2f(up[8]) : 0.f;
        x[1] = bflo(w.x); x[2] = bfhi(w.x); x[3] = bflo(w.y); x[4] = bfhi(w.y); x[5] = bflo(w.z); x[6] = bfhi(w.z); x[7] = bflo(w.w); x[8] = bfhi(w.w);
        const float w0 = sw[d], w1 = sw[3072 + d], w2 = sw[6144 + d], bb = sb[d];
        float y[8];
#pragma unroll
        for (int i = 0; i < 8; ++i) y[i] = x[i] * w0 + x[i + 1] * w1 + x[i + 2] * w2 + bb;
        u32x4 ow; ow.x = cvtpk(y[0], y[1]); ow.y = cvtpk(y[2], y[3]); ow.z = cvtpk(y[4], y[5]); ow.w = cvtpk(y[6], y[7]);
        *(LAS u32x4*)(zb0 + ((ch * NB + b) * ZS + t8) * 2) = ow;
    }
    const int ch = wave >> 2, w4 = wave & 3, d = 2 * cp + ch;
    const int bcol = lane & 15, q = lane >> 4;
#pragma unroll 1
    for (int o = 0; o < 2; ++o) {
        for (int task = tid; task < 2 * (2 * L / 4 + 1); task += NT) {
            const int i = task % (2 * L / 4 + 1), c2 = task / (2 * L / 4 + 1);
            const unsigned long long* gp = (const unsigned long long*)(GP + ((size_t)(o * 1024 + 2 * cp + c2)) * (2 * L));
            const unsigned long long wp = i > 0 ? gp[i - 1] : 0ull, wc = i < 2 * L / 4 ? gp[i] : 0ull;
            LAS unsigned char* ib = img + (c2 * 4) * CS * 2 + i * 8;
            *(LAS unsigned long long*)(ib) = wc;
            *(LAS unsigned long long*)(ib + 1 * CS * 2) = (wp >> 48) | (wc << 16);
            *(LAS unsigned long long*)(ib + 2 * CS * 2) = (wp >> 32) | (wc << 32);
            *(LAS unsigned long long*)(ib + 3 * CS * 2) = (wp >> 16) | (wc << 48);
        }
        __syncthreads();
        const LAS unsigned char* zsrc = (o == 0 ? zb0 : zb1) + (ch * NB) * ZS * 2;
        constexpr int TH = TPW > 8 ? 8 : TPW, NPASS = TPW / TH;
        const int r = lane & 15, c = r & 3;
        const LAS unsigned char* abase = img + ((ch * 4 + c) * CS + (L - r + 8 * q + c)) * 2;
        const int colp = (o + 1) * 1024 + d;
        const float gw0 = sw[colp], gw1 = sw[3072 + colp], gw2 = sw[6144 + colp], gbb = sb[colp], fbo = fb[o * 1024 + d];
        const bf16_t* up0 = UT + (size_t)colp * R + rowbase + (bcol < NB ? bcol : 0) * L;
#pragma unroll 1
        for (int pass = 0; pass < NPASS; ++pass) {
            f32x4 acc[TH];
#pragma unroll
            for (int k = 0; k < TH; ++k) acc[k] = (f32x4){0.f, 0.f, 0.f, 0.f};
            const int tile0 = w4 * TPW + pass * TH;
            bf16x8 aw[TH];
            const LAS unsigned char* ab2 = abase - 32 * tile0;
#define HY_LDA(slot, e) do { const LAS unsigned char* ap_ = ab2 - 32 * (e); const s16x4 lo_ = *(const LAS s16x4*)ap_, hi_ = *(const LAS s16x4*)(ap_ + 8); \
                aw[slot] = (bf16x8){lo_[0], lo_[1], lo_[2], lo_[3], hi_[0], hi_[1], hi_[2], hi_[3]}; } while (0)
#pragma unroll
            for (int k = 0; k < TH; ++k) HY_LDA(k, k);
#pragma unroll 1
            for (int ssb = 0; ssb < NSS; ssb += TH / 2) {
#pragma unroll
                for (int u = 0; u < TH / 2; ++u) {
                    const int ss = ssb + u;
                    bf16x8 bfr = {0, 0, 0, 0, 0, 0, 0, 0};
                    if (bcol < NB) bfr = *(const LAS bf16x8*)(zsrc + (bcol * ZS + 32 * ss + 8 * q) * 2);
#pragma unroll
                    for (int k = 0; k < TH; ++k) acc[k] = __builtin_amdgcn_mfma_f32_16x16x32_bf16(aw[(k - 2 * u + 2 * TH) % TH], bfr, acc[k], 0, 0, 0);
                    if (ss + 1 < NSS) { HY_LDA((TH - 2 - 2 * u + 2 * TH) % TH, -2 * (ss + 1)); HY_LDA((TH - 1 - 2 * u + 2 * TH) % TH, 1 - 2 * (ss + 1)); }
                }
            }
#undef HY_LDA
            if (bcol < NB) {
#pragma unroll 2
                for (int k = 0; k < TH; ++k) {
                    const int t4 = 16 * (tile0 + k) + 4 * q;
                    const bf16_t* up = up0 + t4;
                    const u32x2 w = *(const u32x2*)up;
                    float x[6];
                    x[0] = t4 > 0 ? bf2f(up[-1]) : 0.f; x[5] = t4 + 4 < L ? bf2f(up[4]) : 0.f;
                    x[1] = bflo(w.x); x[2] = bfhi(w.x); x[3] = bflo(w.y); x[4] = bfhi(w.y);
                    const u32x2 zw = *(const LAS u32x2*)(zsrc + (bcol * ZS + t4) * 2);
                    float zv[4] = {bflo(zw.x), bfhi(zw.x), bflo(zw.y), bfhi(zw.y)};
                    float val[4];
#pragma unroll
                    for (int j = 0; j < 4; ++j) { const float pv = x[j] * gw0 + x[j + 1] * gw1 + x[j + 2] * gw2 + gbb; val[j] = pv * (acc[k][j] + zv[j] * fbo); }
                    if (o == 0) { u32x2 ow; ow.x = cvtpk(val[0], val[1]); ow.y = cvtpk(val[2], val[3]); *(LAS u32x2*)(zb1 + ((ch * NB + bcol) * ZS + t4) * 2) = ow; }
                    else {
                        bf16_t* op = AO + (size_t)(rowbase + bcol * L + t4) * D + d;
#pragma unroll
                        for (int j = 0; j < 4; ++j) op[(size_t)j * D] = (unsigned short)(cvtpk(val[j], 0.f) & 0xffffu);
                    }
                }
            }
        }
        __syncthreads();
    }
}
__device__ __forceinline__ void phase_hyena(const Params& P, LAS unsigned char* lds) {
    for (int u = blockIdx.x; u < 1024; u += gridDim.x) {
        if (u < 512) hyena_unit<1024, 8>(P, lds, u, RC);
        else hyena_unit<256, 16>(P, lds, u - 512, 0);
    }
}
#define XB_TMO      128
#define XB_XCNT(j)  (256  + 64 * (j))
#define XB_XSUB(j)  (1280 + 64 * (j))
#define XB_XGEN(j)  (2304 + 64 * (j))
#define XB_TOP      3328
#define XB_TOPGEN   3392
#define XCD_BAR_WORDS 3456
#define XB_SPIN_CAP (1u << 18)

__device__ __forceinline__ unsigned xb_ld(unsigned* p)              { return __hip_atomic_load(p, __ATOMIC_RELAXED, __HIP_MEMORY_SCOPE_AGENT); }
__device__ __forceinline__ unsigned xb_add(unsigned* p, unsigned v) { return __hip_atomic_fetch_add(p, v, __ATOMIC_RELAXED, __HIP_MEMORY_SCOPE_AGENT); }
__device__ __forceinline__ unsigned xb_xcc_id() { return (unsigned)__builtin_amdgcn_s_getreg((3 << 11) | 20) & 0xFu; }
#define XB_SPIN(cond, bar) do { unsigned _sp = 0; while (cond) { __builtin_amdgcn_s_sleep(1); \
    if ((++_sp & 255u) == 0u) { if (xb_ld(&(bar)[XB_TMO])) break; if (_sp > XB_SPIN_CAP) { atomicAdd(&(bar)[XB_TMO], 1u); break; } } } } while (0)

struct XcdBarrier {
    unsigned* bar; unsigned x;
    volatile LAS unsigned* st;
};

__device__ __forceinline__ XcdBarrier xcd_barrier_post(unsigned* bar, volatile LAS unsigned* st) {
    XcdBarrier b; b.bar = bar; b.x = xb_xcc_id(); b.st = st;
    if (threadIdx.x == 0) (void)xb_add(&bar[XB_XCNT(b.x)], 1u);
    return b;
}
__device__ __forceinline__ void xcd_barrier_complete(unsigned* bar, unsigned x, unsigned& nloc, unsigned& nx) {
    const unsigned G = gridDim.x * gridDim.y * gridDim.z;
    unsigned sum, cnt, mine, sp = 0u;
    for (;;) {
        sum = 0u; cnt = 0u; mine = 0u;
#pragma unroll
        for (unsigned j = 0; j < 16; ++j) { const unsigned c = xb_ld(&bar[XB_XCNT(j)]); sum += c; cnt += (c > 0u) ? 1u : 0u; mine = (j == x) ? c : mine; }
        if (sum == G) break;
        __builtin_amdgcn_s_sleep(1);
        if ((++sp & 255u) == 0u) { if (xb_ld(&bar[XB_TMO])) break; if (sp > XB_SPIN_CAP) { atomicAdd(&bar[XB_TMO], 1u); break; } }
    }
    nloc = mine > 0u ? mine : 1u; nx = cnt > 0u ? cnt : 1u;
}

__device__ __forceinline__ void xcd_barrier(const XcdBarrier& b) {
    asm volatile("s_waitcnt vmcnt(0)" ::: "memory");
    __syncthreads();
    if (threadIdx.x == 0) {
        unsigned* bar = b.bar;
        __builtin_amdgcn_s_waitcnt(0);
        unsigned nloc = b.st[0], nx = b.st[1];
        if (nloc == 0u) { xcd_barrier_complete(bar, b.x, nloc, nx); b.st[0] = nloc; b.st[1] = nx; }
        const unsigned old = xb_add(&bar[XB_XSUB(b.x)], 1u);
        const unsigned gen = old / nloc;
        if (old + 1u == (gen + 1u) * nloc) {
            __builtin_amdgcn_fence(__ATOMIC_RELEASE, "agent");
            asm volatile("s_waitcnt vmcnt(0)" ::: "memory");
            const unsigned og = xb_add(&bar[XB_TOP], 1u);
            const unsigned tg = og / nx;
            if (og + 1u == (tg + 1u) * nx) xb_add(&bar[XB_TOPGEN], 1u);
            else XB_SPIN(xb_ld(&bar[XB_TOPGEN]) == tg, bar);
            __builtin_amdgcn_fence(__ATOMIC_ACQUIRE, "agent");
            xb_add(&bar[XB_XGEN(b.x)], 1u);
            asm volatile("s_waitcnt vmcnt(0)" ::: "memory");
        } else {
            XB_SPIN(xb_ld(&bar[XB_XGEN(b.x)]) == gen, bar);
            __builtin_amdgcn_fence(__ATOMIC_ACQUIRE, "agent");
            asm volatile("s_waitcnt vmcnt(0)" ::: "memory");
        }
    }
    __syncthreads();
}

constexpr int N_PHASES = 34;
#ifndef REP_SYNC
#define REP_SYNC 1
#endif
#ifndef REP_PRO
#define REP_PRO 1
#endif
#ifndef REP_MIX
#define REP_MIX 1
#endif
#ifndef REP_LMASK
#define REP_LMASK 0xf
#endif
#ifndef REP_GEMM
#define REP_GEMM 1
#endif
#ifndef EN_MASK
#define EN_MASK 0xfff
#endif
#define EN(b) ((EN_MASK >> (b)) & 1)
__host__ __device__ __forceinline__ bool phase_empty(int ph) { if (ph < 2) return false; const int l = (ph - 2) >> 3, s = (ph - 2) & 7; return s == 1 && (l == 1 || l == 3); }

__global__ void __launch_bounds__(NT, 2) trunk_fwd(Params P) {
    extern __shared__ __attribute__((aligned(16))) unsigned char lds_raw[];
    LAS unsigned char* lds = (LAS unsigned char*)lds_raw;
    cg::grid_group grid = cg::this_grid();
    unsigned char* ws = P.ws;
    float* mod = (float*)(ws + WS_MOD * MiB);
    bf16_t* H = wsb(ws, WS_H); bf16_t* QKV = wsb(ws, WS_QKV); bf16_t* AO = wsb(ws, WS_AO); bf16_t* FF = wsb(ws, WS_FF);
    const int G = gridDim.x, bid = blockIdx.x;
    volatile LAS unsigned* bst = (volatile LAS unsigned*)(lds + LDS_BYTES - 64);
    if (threadIdx.x < 2) bst[threadIdx.x] = 0u;
    __syncthreads();
    XcdBarrier bar = xcd_barrier_post((unsigned*)(ws + WS_CTL * MiB), bst);
    for (int ph = P.ph_lo; ph < P.ph_hi; ++ph) {
        if (phase_empty(ph)) continue;
        if (ph == 0) { for (int rep = 0; rep < REP_PRO; ++rep) { if (EN(0)) prologue(P, lds); if (rep + 1 < REP_PRO) __syncthreads(); } }
        else if (ph == 1) row_pass(P, 0, nullptr, nullptr, mod, 0, 1024);
        else {
            const int l = (ph - 2) >> 3, s = (ph - 2) & 7;
            const float* modl = mod + (size_t)l * 9 * 6144;
            if (s == 0) {
                if (l == 3) {
                    pg8::Gemm g{wsb(ws, WS_WQKV3), H, 3072, R, 1024}; pg8::StaticOrder S; S.init(3072, R, G, bid);
                    EpiQKV E{QKV, R, nullptr, nullptr, 0, 0, 0};
                    for (int rep = 0; rep < REP_GEMM; ++rep) { if (EN(2)) pg8::gemm_phase<EpiQKV, pg8::StaticOrder, true, true>(lds, g, S, E); }
                } else {
                    const int N = l == 2 ? 1536 : 3072;
                    const bf16_t* W = l == 0 ? wsb(ws, WS_WQKV0) : (l == 1 ? wsb(ws, WS_WQKV1) : wsb(ws, WS_WQKV2));
                    pg8::Gemm g{H, W, R, N, 1024}; pg8::StaticOrder S; S.init(R, N, G, bid);
                    EpiQKV E;
                    E.O = QKV; E.ldc = N;
                    if (l == 0) { E.st_k = P.out + OUT_DAK; E.st_v = P.out + OUT_DAV; E.kt0 = 4; E.vt0 = 8; E.st_ld = 1024; }
                    else if (l == 1) { E.st_k = P.out + OUT_NAK; E.st_v = P.out + OUT_NAV; E.kt0 = 4; E.vt0 = 8; E.st_ld = 1024; }
                    else { E.st_k = nullptr; E.st_v = P.out + OUT_GQV; E.kt0 = 4; E.vt0 = 5; E.st_ld = 256; }
                    for (int rep = 0; rep < REP_GEMM; ++rep) { if (EN(2)) pg8::gemm_phase<EpiQKV, pg8::StaticOrder, true, true>(lds, g, S, E); }
                }
            } else if (s == 1) {
                if (l == 0) qkfix(P, QKV, 3072, 32, nullptr, nullptr, nullptr, RC);
                else qkfix(P, QKV, 1536, 20, P.in[25], P.in[26], P.out + OUT_GQK, 0);
            } else if (s == 2) {
              for (int rep = 0; rep < (((REP_LMASK >> l) & 1) ? REP_MIX : 1); ++rep) {
                if (rep) __syncthreads();
                if (l == 0) { if (EN(3)) phase_attn_da(P, lds); }
                else if (l == 1) { if (EN(4)) phase_attn_na(P, lds); }
                else if (l == 2) { if (EN(5)) phase_attn_gq(P, lds); }
                else { if (EN(6)) phase_hyena(P, lds); }
              }
            } else if (s == 3) {
                pg8::Gemm g{AO, wsb(ws, WS_WO + 2 * l), R, 1024, 1024}; pg8::StaticOrder S; S.init(R, 1024, G, bid);
                EpiRes E{P.out, modl + 2048};
                if (EN(7)) pg8::gemm_phase<EpiRes, pg8::StaticOrder, true, true>(lds, g, S, E);
            } else if (s == 4) {
                row_pass(P, 1, P.in[12] + (size_t)(l * 2) * 1024, P.in[13] + (size_t)(l * 2) * 1024, modl, 3072, 4096);
            } else if (s == 5) {
                pg8::Gemm g{H, wsb(ws, WS_W1 + 8 * l), R, FFD, 1024}; pg8::StaticOrder S; S.init(R, FFD, G, bid);
                EpiRelu2 E{FF, FFD};
                for (int rep = 0; rep < REP_GEMM; ++rep) { if (EN(8)) pg8::gemm_phase<EpiRelu2, pg8::StaticOrder, true, true>(lds, g, S, E); }
            } else if (s == 6) {
                pg8::Gemm g{FF, wsb(ws, WS_W2 + 8 * l), R, 1024, FFD}; pg8::StaticOrder S; S.init(R, 1024, G, bid);
                EpiRes E{P.out, modl + 5120};
                if (l < 3 && bid >= 192) { const int t_ = tid_opaque(); transpose_layer(P, l + 1, (LAS float*)(lds + (t_ >> 6) * 8448), (bid - 192) * 8 + (t_ >> 6), (G - 192) * 8, t_ & 63); }
                if (EN(7)) pg8::gemm_phase<EpiRes, pg8::StaticOrder, true, true>(lds, g, S, E);
            } else {
                row_pass(P, 1, P.in[12] + (size_t)(l * 2 + 1) * 1024, P.in[13] + (size_t)(l * 2 + 1) * 1024, l < 3 ? modl + 9 * 6144 : nullptr, 0, 1024);
            }
        }
        if (ph + 1 < P.ph_hi) { for (int rep = 0; rep < REP_SYNC; ++rep) { if (ph == 0) grid.sync(); else xcd_barrier(bar); } }
    }
}

#ifndef MK_MULTI
#define MK_MULTI 0
#endif
extern "C" void kernel_launch(void* const* d_in, const int* in_sizes, int n_in, void* d_out, int out_size, void* d_ws, size_t ws_size, hipStream_t stream) {
    static int grid = 0;
    if (grid == 0) {
        if (n_in != 39 || out_size != (int)OUT_END || ws_size < WS_END * MiB) { fprintf(stderr, "kernel_launch: unexpected shapes (n_in %d out %d ws %zu)\n", n_in, out_size, ws_size); grid = -1; return; }
        int dev = 0, cus = 0, per_cu = 0;
        hipGetDevice(&dev); hipDeviceGetAttribute(&cus, hipDeviceAttributeMultiprocessorCount, dev);
        if (hipFuncSetAttribute((const void*)trunk_fwd, hipFuncAttributeMaxDynamicSharedMemorySize, LDS_BYTES) != hipSuccess) { fprintf(stderr, "kernel_launch: hipFuncSetAttribute failed\n"); grid = -1; return; }
        if (hipOccupancyMaxActiveBlocksPerMultiprocessor(&per_cu, (const void*)trunk_fwd, NT, LDS_BYTES) != hipSuccess || per_cu < 1) { fprintf(stderr, "kernel_launch: occupancy query says %d\n", per_cu); per_cu = 1; }
        (void)hipGetLastError();
        grid = cus * 1;
    }
    if (grid < 0) return;
    if (hipMemsetAsync((char*)d_ws + WS_CTL * MiB, 0, 16384, stream) != hipSuccess) { fprintf(stderr, "kernel_launch: memset failed\n"); return; }
    Params p{};
    for (int i = 0; i < 39; ++i) p.in[i] = (const float*)d_in[i];
    p.out = (float*)d_out; p.ws = (unsigned char*)d_ws;
#if MK_MULTI
    for (int ph = 0; ph < N_PHASES; ++ph) { if (phase_empty(ph)) continue; p.ph_lo = ph; p.ph_hi = ph + 1; hipLaunchKernelGGL(trunk_fwd, dim3(grid), dim3(NT), LDS_BYTES, stream, p); }
#else
    p.ph_lo = 0; p.ph_hi = N_PHASES;
    void* args[] = {&p};
    hipError_t e = hipLaunchCooperativeKernel((const void*)trunk_fwd, dim3(grid), dim3(NT), args, LDS_BYTES, stream);
    if (e != hipSuccess) fprintf(stderr, "cooperative launch failed: %s (grid %d)\n", hipGetErrorString(e), grid);
#endif
}
```

```cpp
#include <hip/hip_runtime.h>
#include <hip/hip_cooperative_groups.h>
#include <cstdio>
#include <cstdint>
namespace cg = cooperative_groups;
__device__ __forceinline__ int tid_opaque() { int t = threadIdx.x; asm volatile("" : "+v"(t)); return t; }
namespace pg8 {
#define PG8_LAS __attribute__((address_space(3)))
typedef unsigned short bf16_t;
typedef short bf16x8 __attribute__((ext_vector_type(8)));
typedef float f32x4 __attribute__((ext_vector_type(4)));
typedef unsigned u32x4 __attribute__((ext_vector_type(4)));
constexpr int BM = 256, BK = 64, HALF = 128, HTB = HALF * BK * 2  , STAGE_BYTES = 8 * HTB, NXCD = 8, WGM = 8;

__host__ __device__ __forceinline__ int lds_byte(int r, int c) { const int st = (r >> 4) * 2 + (c >> 5), rr = r & 15, cc = c & 31, ob = rr * 64 + cc * 2; return st * 1024 + (ob ^ (((ob >> 9) & 1) << 5)); }
__host__ __device__ __forceinline__ void stage_rc(int b, int& R, int& C) { const int st = b / 1024, sb = b % 1024, swz = sb ^ (((sb >> 9) & 1) << 5); R = (st >> 1) * 16 + swz / 64; C = (st & 1) * 32 + (swz % 64) / 2; }
__host__ __device__ __forceinline__ int perm32(int rho) { const int n = rho >> 4, i = rho & 15; return 8 * (i >> 2) + 4 * n + (i & 3); }

struct Unit { int pm, pn; };
struct Gemm { const bf16_t* A; const bf16_t* Bt; int M, N, K; };

struct StaticOrder {
    int nM, nN, nwg, G, c;
    __host__ __device__ void init(int M, int N, int G_, int c_) { nM = M / BM; nN = N / BM; nwg = nM * nN; G = G_; c = c_; }
    __host__ __device__ bool next(int i, Unit& u) const {
        const long L = (long)i * G + c; if (L >= nwg) return false;
        int wgid = (int)L; { const int q = nwg / NXCD, r = nwg % NXCD, xcd = wgid % NXCD, off = wgid / NXCD; wgid = (xcd < r ? xcd * (q + 1) : r * (q + 1) + (xcd - r) * q) + off; }
        const int nig = WGM * nN, gid = wgid / nig, fm = gid * WGM, gsz = (nM - fm) < WGM ? (nM - fm) : WGM;
        u.pm = fm + ((wgid % nig) % gsz); u.pn = (wgid % nig) / gsz; return true;
    }
    __device__ __forceinline__ void a_ready(const Unit&) const {}
    __device__ __forceinline__ void done(const Unit&) const {}
};

template <class Epi, class Sched, bool ALIGN_EPI = false, bool SP2 = false>
__device__ __forceinline__ void gemm_phase(PG8_LAS unsigned char* lds, const Gemm g, const Sched& S, const Epi& E) {
    const int tid = tid_opaque(), wid = __builtin_amdgcn_readfirstlane(tid >> 6), lane = tid & 63, wr = wid >> 2, wc = wid & 3, fr = lane & 15, fq = lane >> 4;
    const int K = g.K, nt = K / BK;
    unsigned voffA[2], voffB[2];
#pragma unroll
    for (int i = 0; i < 2; ++i) { int R, C; stage_rc(tid * 16 + i * 8192, R, C); const int Rb = Epi::PERM ? ((R & ~31) + perm32(R & 31)) : R;
        voffA[i] = (unsigned)(R * K + C) * 2u; voffB[i] = (unsigned)(Rb * K + C) * 2u; }
    const size_t kstep = (size_t)(BK * 2);
    const size_t hstep = (size_t)HALF * K * 2;
    const size_t tstep = 2 * hstep;
    const unsigned ldsw = (unsigned)wid * 1024u;
    const int aoff = lds_byte(wr * 64 + fr, fq * 8), boff = lds_byte(wc * 32 + fr, fq * 8);
#define PG8_SA(b, h) (((b) * 2 + (h)) * HTB)
#define PG8_SB(b, h) ((4 + (b) * 2 + (h)) * HTB)
#define PG8_STAGE(bufoff, gbase, voff) do { _Pragma("unroll") for (int _i = 0; _i < 2; ++_i) \
        __builtin_amdgcn_global_load_lds((const unsigned*)((const char*)(gbase) + (voff)[_i]), (PG8_LAS unsigned*)(lds + (bufoff) + ldsw + _i * 8192), 16, 0, 0); } while (0)
#define PG8_LDA(dst, b, h) do { _Pragma("unroll") for (int m = 0; m < 4; ++m) _Pragma("unroll") for (int k = 0; k < 2; ++k) dst[m][k] = *(const PG8_LAS bf16x8*)(lds + PG8_SA(b, h) + aoff + m * 2048 + k * 1024); } while (0)
#define PG8_LDB(dst, b, h) do { _Pragma("unroll") for (int n = 0; n < 2; ++n) _Pragma("unroll") for (int k = 0; k < 2; ++k) dst[n][k] = *(const PG8_LAS bf16x8*)(lds + PG8_SB(b, h) + boff + n * 2048 + k * 1024); } while (0)
#define PG8_MMA(ai, bj, At, Bt) do { __builtin_amdgcn_s_setprio(1); _Pragma("unroll") for (int m = 0; m < 4; ++m) _Pragma("unroll") for (int n = 0; n < 2; ++n) _Pragma("unroll") for (int k = 0; k < 2; ++k) \
        acc[ai][bj][m][n] = __builtin_amdgcn_mfma_f32_16x16x32_bf16(Bt[n][k], At[m][k], acc[ai][bj][m][n], 0, 0, 0); __builtin_amdgcn_s_setprio(0); } while (0)
#define PG8_WAIT_V(n) asm volatile("s_waitcnt vmcnt(" #n ")" ::: "memory")
#define PG8_WAIT_L(n) asm volatile("s_waitcnt lgkmcnt(" #n ")" ::: "memory")
#define PG8_BAR __builtin_amdgcn_s_barrier()
#define PG8_SCHED __builtin_amdgcn_sched_barrier(0)
    Unit cur, nxt; int ui = 0;
    if (!S.next(0, cur)) return;
    f32x4 acc[2][2][4][2];
#pragma unroll
    for (int a = 0; a < 2; ++a)
#pragma unroll
        for (int b = 0; b < 2; ++b)
#pragma unroll
            for (int m = 0; m < 4; ++m)
#pragma unroll
                for (int n = 0; n < 2; ++n) acc[a][b][m][n] = (f32x4){0.f, 0.f, 0.f, 0.f};
    bf16x8 At[4][2], B0[2][2], B1[2][2];
    const char* cA = (const char*)g.A + (size_t)cur.pm * tstep; const char* cB = (const char*)g.Bt + (size_t)cur.pn * tstep;
    S.a_ready(cur);
    if constexpr (SP2) {
        PG8_STAGE(PG8_SB(0, 0), cB, voffB); PG8_STAGE(PG8_SB(0, 1), cB + hstep, voffB); PG8_STAGE(PG8_SA(0, 0), cA, voffA); PG8_STAGE(PG8_SA(0, 1), cA + hstep, voffA);
        if (wr == 1) PG8_BAR;
        PG8_WAIT_V(2); PG8_BAR;
        PG8_STAGE(PG8_SB(1, 0), cB + kstep, voffB); PG8_STAGE(PG8_SA(1, 0), cA + kstep, voffA); PG8_STAGE(PG8_SB(1, 1), cB + hstep + kstep, voffB);
        PG8_WAIT_V(6); PG8_BAR;
    } else {
        PG8_STAGE(PG8_SB(0, 0), cB, voffB); PG8_STAGE(PG8_SA(0, 0), cA, voffA); PG8_STAGE(PG8_SB(0, 1), cB + hstep, voffB); PG8_STAGE(PG8_SA(0, 1), cA + hstep, voffA);
        if (wr == 1) PG8_BAR;
        PG8_WAIT_V(4); PG8_BAR;
        PG8_STAGE(PG8_SB(1, 0), cB + kstep, voffB); PG8_STAGE(PG8_SA(1, 0), cA + kstep, voffA); PG8_STAGE(PG8_SB(1, 1), cB + hstep + kstep, voffB);
        PG8_WAIT_V(6); PG8_BAR;
    }
    for (;;) {
        const bool has_next = S.next(ui + 1, nxt);
        const char* nA = has_next ? (const char*)g.A + (size_t)nxt.pm * tstep : cA; const char* nB = has_next ? (const char*)g.Bt + (size_t)nxt.pn * tstep : cB;
        for (int t = 0; t < nt; t += 2) {
            const bool last = (t == nt - 2);
            const char* a1 = cA + (size_t)(t + 1) * kstep;
            const char* a2 = last ? nA : cA + (size_t)(t + 2) * kstep; const char* b2 = last ? nB : cB + (size_t)(t + 2) * kstep;
            const char* a3 = a2 + kstep; const char* b3 = b2 + kstep;
            if (last && has_next) S.a_ready(nxt);
            if constexpr (SP2) {
            PG8_LDB(B0, 0, 0); PG8_LDB(B1, 0, 1); PG8_SCHED; PG8_LDA(At, 0, 0); PG8_STAGE(PG8_SA(1, 1), a1 + hstep, voffA);
            PG8_WAIT_V(8); PG8_WAIT_L(0); PG8_BAR; PG8_MMA(0, 0, At, B0); PG8_MMA(0, 1, At, B1); PG8_BAR; PG8_SCHED;
            PG8_LDA(At, 0, 1); PG8_STAGE(PG8_SB(0, 0), b2, voffB); PG8_STAGE(PG8_SB(0, 1), b2 + hstep, voffB); PG8_STAGE(PG8_SA(0, 0), a2, voffA);
            PG8_WAIT_V(8); PG8_WAIT_L(0); PG8_BAR; PG8_MMA(1, 0, At, B0); PG8_MMA(1, 1, At, B1); PG8_BAR; PG8_SCHED;
            PG8_LDB(B0, 1, 0); PG8_LDB(B1, 1, 1); PG8_SCHED; PG8_LDA(At, 1, 0); PG8_STAGE(PG8_SA(0, 1), a2 + hstep, voffA);
            PG8_WAIT_V(8); PG8_WAIT_L(0); PG8_BAR; PG8_MMA(0, 0, At, B0); PG8_MMA(0, 1, At, B1); PG8_BAR; PG8_SCHED;
            PG8_LDA(At, 1, 1); PG8_STAGE(PG8_SB(1, 0), b3, voffB); PG8_STAGE(PG8_SB(1, 1), b3 + hstep, voffB); PG8_STAGE(PG8_SA(1, 0), a3, voffA);
            PG8_WAIT_V(8); PG8_WAIT_L(0); PG8_BAR; PG8_MMA(1, 0, At, B0); PG8_MMA(1, 1, At, B1); PG8_BAR; PG8_SCHED;
            } else {
            PG8_LDB(B0, 0, 0); PG8_SCHED; PG8_LDA(At, 0, 0); PG8_STAGE(PG8_SA(1, 1), a1 + hstep, voffA);
            PG8_WAIT_L(8); PG8_BAR; PG8_WAIT_L(0); PG8_MMA(0, 0, At, B0); PG8_BAR; PG8_SCHED;
            PG8_LDB(B1, 0, 1); PG8_STAGE(PG8_SB(0, 0), b2, voffB);
            PG8_BAR; PG8_WAIT_L(0); PG8_MMA(0, 1, At, B1); PG8_BAR;
            PG8_LDA(At, 0, 1); PG8_STAGE(PG8_SA(0, 0), a2, voffA);
            PG8_BAR; PG8_WAIT_L(0); PG8_MMA(1, 0, At, B0); PG8_BAR; PG8_SCHED;
            PG8_STAGE(PG8_SB(0, 1), b2 + hstep, voffB);
            PG8_WAIT_V(6); PG8_BAR; PG8_MMA(1, 1, At, B1); PG8_BAR;
            PG8_LDB(B0, 1, 0); PG8_SCHED; PG8_LDA(At, 1, 0); PG8_STAGE(PG8_SA(0, 1), a2 + hstep, voffA);
            PG8_WAIT_L(8); PG8_BAR; PG8_WAIT_L(0); PG8_MMA(0, 0, At, B0); PG8_BAR; PG8_SCHED;
            PG8_LDB(B1, 1, 1); PG8_STAGE(PG8_SB(1, 0), b3, voffB);
            PG8_BAR; PG8_WAIT_L(0); PG8_MMA(0, 1, At, B1); PG8_BAR;
            PG8_LDA(At, 1, 1); PG8_STAGE(PG8_SA(1, 0), a3, voffA);
            PG8_BAR; PG8_WAIT_L(0); PG8_MMA(1, 0, At, B0); PG8_BAR; PG8_SCHED;
            PG8_STAGE(PG8_SB(1, 1), b3 + hstep, voffB);
            PG8_WAIT_V(6); PG8_BAR; PG8_MMA(1, 1, At, B1); PG8_BAR;
            }
        }
        if constexpr (ALIGN_EPI) { if (wr == 0) PG8_BAR; }
        if constexpr (!Epi::AFTER_DRAIN) { E(acc, cur, wr, wc, fr, fq); S.done(cur); }
        if (!has_next) break;
#pragma unroll
        for (int a = 0; a < 2; ++a)
#pragma unroll
            for (int b = 0; b < 2; ++b)
#pragma unroll
                for (int m = 0; m < 4; ++m)
#pragma unroll
                    for (int n = 0; n < 2; ++n) acc[a][b][m][n] = (f32x4){0.f, 0.f, 0.f, 0.f};
        cur = nxt; cA = nA; cB = nB; ++ui;
        if constexpr (ALIGN_EPI) { if (wr == 1) PG8_BAR; }
    }
    PG8_WAIT_V(0);
    if constexpr (!ALIGN_EPI) { if (wr == 0) PG8_BAR; }
    PG8_BAR;
    if constexpr (Epi::AFTER_DRAIN) { E.fused(acc, cur, wr, wc, fr, fq, lds, wid, lane); S.done(cur); }
#undef PG8_SA
#undef PG8_SB
#undef PG8_STAGE
#undef PG8_LDA
#undef PG8_LDB
#undef PG8_MMA
#undef PG8_WAIT_V
#undef PG8_WAIT_L
#undef PG8_BAR
#undef PG8_SCHED
}
}
typedef unsigned short bf16_t;
typedef short bf16x8 __attribute__((ext_vector_type(8)));
typedef short s16x4 __attribute__((ext_vector_type(4)));
typedef float f32x4 __attribute__((ext_vector_type(4)));
typedef float f32x2 __attribute__((ext_vector_type(2)));
typedef float f32x16 __attribute__((ext_vector_type(16)));
typedef unsigned u32x4 __attribute__((ext_vector_type(4)));
typedef unsigned u32x2 __attribute__((ext_vector_type(2)));
typedef __bf16 bf16x2_t __attribute__((ext_vector_type(2)));
#define LAS __attribute__((address_space(3)))
constexpr int NT = 512;
constexpr int D = 1024, R = 12288, RC = 4096, FFD = 4096;
constexpr int LDS_BYTES = 147456;
constexpr size_t MiB = 1u << 20;
constexpr size_t WS_WQKV0 = 0, WS_WQKV1 = 6, WS_WQKV2 = 12, WS_WQKV3 = 15, WS_WO = 21  , WS_W1 = 29  , WS_W2 = 61  ;
constexpr size_t WS_MOD = 93, WS_H = 94, WS_QKV = 118, WS_AO = 190, WS_FF = 118;
constexpr size_t WS_CTL = 242;
constexpr size_t WS_CKDA = 214, WS_CVDA = 218, WS_CKNA = 222, WS_CVNA = 226, WS_CKGQ = 230, WS_CVGQ = 231, WS_GP1 = 232, WS_GP0 = 240, WS_END = 243;
constexpr size_t OUT_DAK = 12582912, OUT_DAV = 16777216, OUT_NAK = 20971520, OUT_NAV = 25165824, OUT_GQK = 29360128, OUT_GQV = 30408704, OUT_END = 31457280;
constexpr float DN_ALPHA = 1.681792830507429f;
constexpr float LOG2E = 1.4426950408889634f;

struct Params { const float* in[39]; float* out; unsigned char* ws; int ph_lo, ph_hi; };

__device__ __forceinline__ unsigned cvtpk(float lo, float hi) { f32x2 v = {lo, hi}; bf16x2_t b = __builtin_convertvector(v, bf16x2_t); return __builtin_bit_cast(unsigned, b); }
__device__ __forceinline__ float bf2f(unsigned short x) { return __uint_as_float(((unsigned)x) << 16); }
__device__ __forceinline__ float bflo(unsigned w) { return __uint_as_float(w << 16); }
__device__ __forceinline__ float bfhi(unsigned w) { return __uint_as_float(w & 0xffff0000u); }
__device__ __forceinline__ float wave_sum(float v) {
#pragma unroll
    for (int o = 1; o < 64; o <<= 1) v += __shfl_xor(v, o);
    return v;
}
__device__ __forceinline__ bf16_t* wsb(unsigned char* ws, size_t mib) { return (bf16_t*)(ws + mib * MiB); }
__device__ __forceinline__ int crow(int r, int hi) { return (r & 3) + 8 * (r >> 2) + 4 * hi; }

struct EpiQKV {
    static constexpr bool PERM = true, AFTER_DRAIN = false;
    bf16_t* O; int ldc; float* st_k; float* st_v; int kt0, vt0, st_ld;
    __device__ __forceinline__ void operator()(const f32x4 (&acc)[2][2][4][2], const pg8::Unit& u, int wr, int wc, int fr, int fq) const {
        const int row0 = u.pm * 256 + wr * 64 + fr, col0 = u.pn * 256 + wc * 32 + 8 * fq;
        float* st = nullptr; int scol0 = 0;
        if (u.pm < 16) {
            if (st_v && u.pn >= vt0) { st = st_v; scol0 = col0 - vt0 * 256; }
            else if (st_k && u.pn >= kt0 && u.pn < vt0) { st = st_k; scol0 = col0 - kt0 * 256; }
        }
#pragma unroll
        for (int ai = 0; ai < 2; ++ai)
#pragma unroll
            for (int m = 0; m < 4; ++m) {
                const int row = row0 + ai * 128 + m * 16;
                bf16_t* rowp = O + (size_t)row * ldc + col0;
#pragma unroll
                for (int bj = 0; bj < 2; ++bj) {
                    const f32x4 v0 = acc[ai][bj][m][0], v1 = acc[ai][bj][m][1];
                    u32x4 w; w.x = cvtpk(v0[0], v0[1]); w.y = cvtpk(v0[2], v0[3]); w.z = cvtpk(v1[0], v1[1]); w.w = cvtpk(v1[2], v1[3]);
                    *(u32x4*)(rowp + bj * 128) = w;
                    if (st) { float* sp = st + (size_t)row * st_ld + scol0 + bj * 128; *(f32x4*)sp = v0; *(f32x4*)(sp + 4) = v1; }
                }
            }
    }
};
struct EpiRelu2 {
    static constexpr bool PERM = true, AFTER_DRAIN = false;
    bf16_t* O; int ldc;
    __device__ __forceinline__ void operator()(const f32x4 (&acc)[2][2][4][2], const pg8::Unit& u, int wr, int wc, int fr, int fq) const {
        const int row0 = u.pm * 256 + wr * 64 + fr, col0 = u.pn * 256 + wc * 32 + 8 * fq;
#pragma unroll
        for (int ai = 0; ai < 2; ++ai)
#pragma unroll
            for (int m = 0; m < 4; ++m) {
                bf16_t* rowp = O + (size_t)(row0 + ai * 128 + m * 16) * ldc + col0;
#pragma unroll
                for (int bj = 0; bj < 2; ++bj) {
                    f32x4 v0 = acc[ai][bj][m][0], v1 = acc[ai][bj][m][1];
#pragma unroll
                    for (int i = 0; i < 4; ++i) { float a = fmaxf(v0[i], 0.f), b = fmaxf(v1[i], 0.f); v0[i] = a * a; v1[i] = b * b; }
                    u32x4 w; w.x = cvtpk(v0[0], v0[1]); w.y = cvtpk(v0[2], v0[3]); w.z = cvtpk(v1[0], v1[1]); w.w = cvtpk(v1[2], v1[3]);
                    *(u32x4*)(rowp + bj * 128) = w;
                }
            }
    }
};
struct EpiRes {
    static constexpr bool PERM = false, AFTER_DRAIN = false;
    float* X; const float* gate0;
    __device__ __forceinline__ void operator()(const f32x4 (&acc)[2][2][4][2], const pg8::Unit& u, int wr, int wc, int fr, int fq) const {
        const int row0 = u.pm * 256 + wr * 64 + fr, col0 = u.pn * 256 + wc * 32 + 4 * fq;
        const int j = u.pm < 16 ? 0 : 1 + ((u.pm - 16) >> 2);
        const float* g = gate0 + (size_t)j * 6144 + col0;
        f32x4 gv[2][2];
#pragma unroll
        for (int bj = 0; bj < 2; ++bj)
#pragma unroll
            for (int n = 0; n < 2; ++n) gv[bj][n] = *(const f32x4*)(g + bj * 128 + n * 16);
#pragma unroll
        for (int ai = 0; ai < 2; ++ai)
#pragma unroll
            for (int m = 0; m < 4; ++m) {
                float* rowp = X + (size_t)(row0 + ai * 128 + m * 16) * D + col0;
#pragma unroll
                for (int bj = 0; bj < 2; ++bj)
#pragma unroll
                    for (int n = 0; n < 2; ++n) {
                        float* p = rowp + bj * 128 + n * 16;
                        const f32x4 x = *(const f32x4*)p;
                        *(f32x4*)p = x * DN_ALPHA + gv[bj][n] * acc[ai][bj][m][n];
                    }
            }
    }
};
__device__ __forceinline__ void transpose_item(const float* W, int K, int N, bf16_t* WT, LAS float* scr, int item, int lane) {
    const int nblk = N / 32, kb = item / nblk, nb = item % nblk, k0 = 64 * kb, n0 = 32 * nb;
    float tv[32];
    const float* wp = W + (size_t)(k0 + (lane >> 5)) * N + n0 + (lane & 31);
#pragma unroll
    for (int i = 0; i < 32; ++i) tv[i] = wp[(size_t)(2 * i) * N];
#pragma unroll
    for (int i = 0; i < 32; ++i) scr[(2 * i + (lane >> 5)) * 33 + (lane & 31)] = tv[i];
    asm volatile("s_waitcnt lgkmcnt(0)" ::: "memory");
    const int c = lane & 7;
#pragma unroll
    for (int j = 0; j < 4; ++j) { const int n = (lane >> 3) + 8 * j; const LAS float* s = scr + (8 * c) * 33 + n;
        u32x4 o; o.x = cvtpk(s[0 * 33], s[1 * 33]); o.y = cvtpk(s[2 * 33], s[3 * 33]); o.z = cvtpk(s[4 * 33], s[5 * 33]); o.w = cvtpk(s[6 * 33], s[7 * 33]);
        *(u32x4*)(WT + (size_t)(n0 + n) * K + k0 + 8 * c) = o; }
    asm volatile("s_waitcnt lgkmcnt(0)" ::: "memory");
}
__device__ __forceinline__ void cvt_range(const float* src, bf16_t* dst, int n, int gtid, int gthreads) {
    for (int i = gtid * 4; i < n; i += gthreads * 4) { const f32x4 v = *(const f32x4*)(src + i); u32x2 w; w.x = cvtpk(v[0], v[1]); w.y = cvtpk(v[2], v[3]); *(u32x2*)(dst + i) = w; }
}
__device__ __forceinline__ float silu_f(float x) { return x / (1.f + expf(-x)); }

__device__ __forceinline__ void transpose_layer(const Params& P, int l, LAS float* scr, int gw, int ngw, int lane) {
    unsigned char* ws = P.ws;
    const int NQ = l == 2 ? 1536 : 3072;
    const int IQ = 16 * (NQ / 32), IO = 16 * 32, IW1 = 16 * 128, IW2 = 64 * 32;
    const float* wq = l == 0 ? P.in[16] : l == 1 ? P.in[20] : l == 2 ? P.in[23] : P.in[27];
    const float* wo = l == 0 ? P.in[17] : l == 1 ? P.in[21] : l == 2 ? P.in[24] : P.in[38];
    bf16_t* tq = l == 0 ? wsb(ws, WS_WQKV0) : l == 1 ? wsb(ws, WS_WQKV1) : l == 2 ? wsb(ws, WS_WQKV2) : wsb(ws, WS_WQKV3);
    for (int it = gw; it < IQ + IO + IW1 + IW2; it += ngw) {
        int r = it;
        if (r < IQ) { transpose_item(wq, 1024, NQ, tq, scr, r, lane); continue; } r -= IQ;
        if (r < IO) { transpose_item(wo, 1024, 1024, wsb(ws, WS_WO + 2 * l), scr, r, lane); continue; } r -= IO;
        if (r < IW1) { transpose_item(P.in[14] + (size_t)l * 1024 * 4096, 1024, 4096, wsb(ws, WS_W1 + 8 * l), scr, r, lane); continue; } r -= IW1;
        transpose_item(P.in[15] + (size_t)l * 4096 * 1024, 4096, 1024, wsb(ws, WS_W2 + 8 * l), scr, r, lane);
    }
}

__device__ __forceinline__ void prologue(const Params& P, LAS unsigned char* lds) {
    const int tid = tid_opaque(), lane = tid & 63, wave = tid >> 6, G = gridDim.x, bid = blockIdx.x;
    unsigned char* ws = P.ws;
    {
        LAS float* sv = (LAS float*)lds;
        LAS float* red = (LAS float*)(lds + 36864);
        for (int i = tid; i < 9 * 1024; i += NT) { const int j = i >> 10, k = i & 1023; const float x = j == 0 ? P.in[9][k] : P.in[2][(j - 1) * 1024 + k]; sv[i] = silu_f(x); }
        __syncthreads();
        float* mod = (float*)(ws + WS_MOD * MiB);
        for (int item = bid; item < 4 * 96; item += G) {
            const int l = item / 96, n0 = (item % 96) * 64, ks = tid >> 5, ln = tid & 31;
            const float* W = P.in[10] + (size_t)l * 1024 * 6144 + n0 + 2 * ln;
            float a0[9], a1[9];
#pragma unroll
            for (int j = 0; j < 9; ++j) { a0[j] = 0.f; a1[j] = 0.f; }
#pragma unroll 4
            for (int kk = 0; kk < 64; ++kk) {
                const int k = ks * 64 + kk; const f32x2 w = *(const f32x2*)(W + (size_t)k * 6144);
#pragma unroll
                for (int j = 0; j < 9; ++j) { const float s = sv[j * 1024 + k]; a0[j] += s * w.x; a1[j] += s * w.y; }
            }
#pragma unroll
            for (int j = 0; j < 9; ++j) { red[(ks * 9 + j) * 64 + 2 * ln] = a0[j]; red[(ks * 9 + j) * 64 + 2 * ln + 1] = a1[j]; }
            __syncthreads();
            for (int idx = tid; idx < 576; idx += NT) { const int j = idx >> 6, n = idx & 63; float s = P.in[11][l * 6144 + n0 + n];
#pragma unroll
                for (int q = 0; q < 16; ++q) s += red[(q * 9 + j) * 64 + n];
                mod[(size_t)(l * 9 + j) * 6144 + n0 + n] = s; }
            __syncthreads();
        }
    }
    {
        LAS float* emb = (LAS float*)lds;
        LAS float* h1T = (LAS float*)(lds + 8448);
        LAS float* h2T = (LAS float*)(lds + 8448 + 16384);
        const float* w1 = P.in[30]; const float* b1 = P.in[31]; const float* w2 = P.in[32]; const float* b2 = P.in[33]; const float* fq = P.in[34]; const float* w3 = P.in[35]; const float* ld = P.in[36];
        for (int item = bid; item < 20 * 64; item += G) {
            const int pc = item >> 6, cc = item & 63;
            const int L = pc < 16 ? 1024 : 256, p0 = (pc < 16 ? pc : pc - 16) * 64;
            bf16_t* GP = pc < 16 ? wsb(ws, WS_GP1) : wsb(ws, WS_GP0);
            for (int i = tid; i < 64 * 33; i += NT) { const int pos = i / 33, e = i % 33; const int ti = p0 + pos; float v;
                if (e == 0) v = (float)ti / (float)L;
                else { const int band = e <= 16 ? e : e - 16; const int ph = (ti * band) & (L - 1); const float a = 6.283185307179586f * ((float)ph / (float)L); v = e <= 16 ? cosf(a) : sinf(a); }
                emb[pos * 33 + e] = v; }
            __syncthreads();
            const int pos = lane;
            {
                float sa[8];
#pragma unroll
                for (int kk = 0; kk < 8; ++kk) sa[kk] = b1[wave * 8 + kk];
#pragma unroll 1
                for (int e = 0; e < 33; ++e) { const float ev = emb[pos * 33 + e]; const float* wp = w1 + e * 64 + wave * 8;
#pragma unroll
                    for (int kk = 0; kk < 8; ++kk) sa[kk] += ev * wp[kk]; }
#pragma unroll
                for (int kk = 0; kk < 8; ++kk) h1T[(wave * 8 + kk) * 64 + pos] = sinf(fq[wave * 8 + kk] * sa[kk]);
            }
            __syncthreads();
            {
                float sa[8];
#pragma unroll
                for (int kk = 0; kk < 8; ++kk) sa[kk] = b2[wave * 8 + kk];
#pragma unroll 1
                for (int j = 0; j < 64; ++j) { const float hv = h1T[j * 64 + pos]; const float* wp = w2 + j * 64 + wave * 8;
#pragma unroll
                    for (int kk = 0; kk < 8; ++kk) sa[kk] += hv * wp[kk]; }
#pragma unroll
                for (int kk = 0; kk < 8; ++kk) h2T[(wave * 8 + kk) * 64 + pos] = sinf(fq[wave * 8 + kk] * sa[kk]);
            }
            __syncthreads();
            float acc[8];
#pragma unroll
            for (int c = 0; c < 8; ++c) acc[c] = 0.f;
            const int col0 = cc * 64 + wave * 8;
#pragma unroll 1
            for (int k = 0; k < 64; ++k) { const float hv = h2T[k * 64 + pos]; const float* wr = w3 + (size_t)k * 4096 + col0;
#pragma unroll
                for (int c = 0; c < 8; ++c) acc[c] += hv * wr[c]; }
            const int ti = p0 + pos; const float t = (float)ti / (float)L;
#pragma unroll
            for (int c = 0; c < 8; ++c) { const int col = col0 + c; const int o = col >> 11, dir = (col >> 10) & 1, d = col & 1023;
                const float val = acc[c] * expf(-expf(ld[col]) * t);
                bf16_t* g = GP + ((size_t)(o * 1024 + d)) * (2 * L);
                unsigned short bv = (unsigned short)(cvtpk(val, 0.f) & 0xffffu);
                if (dir == 0) g[L - ti] = bv; else { if (ti > 0) g[L + ti] = bv; else g[0] = 0; } }
            __syncthreads();
        }
    }
    {
        const int gtid = bid * NT + tid, gth = G * NT;
        cvt_range(P.in[3], wsb(ws, WS_CKDA), 8 * 256 * 1024, gtid, gth); cvt_range(P.in[4], wsb(ws, WS_CVDA), 8 * 256 * 1024, gtid, gth);
        cvt_range(P.in[5], wsb(ws, WS_CKNA), 8 * 256 * 1024, gtid, gth); cvt_range(P.in[6], wsb(ws, WS_CVNA), 8 * 256 * 1024, gtid, gth);
        cvt_range(P.in[7], wsb(ws, WS_CKGQ), 8 * 256 * 256, gtid, gth);  cvt_range(P.in[8], wsb(ws, WS_CVGQ), 8 * 256 * 256, gtid, gth);
    }
    transpose_layer(P, 0, (LAS float*)(lds + wave * 8448), bid * 8 + wave, G * 8, lane);
}

__device__ __forceinline__ void row_pass(const Params& P, int mode, const float* g, const float* bta, const float* modH, int shoff, int scoff) {
    const int tid = tid_opaque(), lane = tid & 63, wave = tid >> 6;
    float* X = P.out; bf16_t* H = wsb(P.ws, WS_H);
    for (int row = blockIdx.x * 8 + wave; row < R; row += gridDim.x * 8) {
        const float* src = mode == 0 ? (row < RC ? P.in[0] + (size_t)row * D : P.in[1] + (size_t)(row - RC) * D) : X + (size_t)row * D;
        f32x4 v[4];
#pragma unroll
        for (int j = 0; j < 4; ++j) v[j] = *(const f32x4*)(src + 4 * lane + 256 * j);
        if (mode == 1) {
            float s = 0.f;
#pragma unroll
            for (int j = 0; j < 4; ++j) s += (v[j][0] + v[j][1]) + (v[j][2] + v[j][3]);
            const float mean = wave_sum(s) * (1.f / D); float s2 = 0.f;
#pragma unroll
            for (int j = 0; j < 4; ++j) { v[j] = v[j] - mean; s2 += (v[j][0] * v[j][0] + v[j][1] * v[j][1]) + (v[j][2] * v[j][2] + v[j][3] * v[j][3]); }
            const float rstd = 1.f / sqrtf(wave_sum(s2) * (1.f / D) + 1e-5f);
#pragma unroll
            for (int j = 0; j < 4; ++j) { const f32x4 gg = *(const f32x4*)(g + 4 * lane + 256 * j), bb = *(const f32x4*)(bta + 4 * lane + 256 * j); v[j] = v[j] * rstd * gg + bb; }
        }
#pragma unroll
        for (int j = 0; j < 4; ++j) *(f32x4*)(X + (size_t)row * D + 4 * lane + 256 * j) = v[j];
        if (modH) {
            const int jm = row < RC ? 0 : 1 + ((row - RC) >> 10);
            const float* m = modH + (size_t)jm * 6144;
#pragma unroll
            for (int j = 0; j < 4; ++j) { const int c = 4 * lane + 256 * j; const f32x4 sh = *(const f32x4*)(m + shoff + c), sc = *(const f32x4*)(m + scoff + c);
                const f32x4 h = v[j] * (sc + 1.0f) + sh; u32x2 w; w.x = cvtpk(h[0], h[1]); w.y = cvtpk(h[2], h[3]); *(u32x2*)(H + (size_t)row * D + c) = w; }
        }
    }
}

__device__ __forceinline__ void qkfix(const Params& P, bf16_t* base, int ld, int ngroups, const float* qn, const float* kn, float* st_k, int row_lo) {
    const int tid = tid_opaque(), lane = tid & 63, wave = tid >> 6;
    const int i = lane & 15, part = (lane >> 4) & 1, gpar = lane >> 5;
    const float inv = exp2f(-(float)i * (13.287712379549449f / 16.f));
    for (int row = row_lo + blockIdx.x * 8 + wave; row < R; row += gridDim.x * 8) {
        const bool lat = row >= RC; float cs = 1.f, sn = 0.f;
        if (lat) { const int t = (row - RC) & 1023; const int pos = part ? (t & 63) : (t >> 6); const float a = (float)pos * inv; cs = cosf(a); sn = sinf(a); }
        bf16_t* rp = base + (size_t)row * ld;
        for (int k = 0; k < ngroups / 2; ++k) {
            const int gI = 2 * k + gpar; const int c1 = gI * 64 + part * 32 + i, c2 = c1 + 16;
            float x1 = bf2f(rp[c1]), x2 = bf2f(rp[c2]);
            if (qn) {
                float ss = x1 * x1 + x2 * x2;
#pragma unroll
                for (int o = 1; o < 32; o <<= 1) ss += __shfl_xor(ss, o);
                const float rstd = 1.f / sqrtf(ss * (1.f / 64.f) + 1e-6f);
                const float* w = gI < 16 ? qn : kn;
                x1 = x1 * rstd * w[part * 32 + i]; x2 = x2 * rstd * w[part * 32 + i + 16];
            }
            if (lat) { const float y1 = x1 * cs - x2 * sn, y2 = x1 * sn + x2 * cs; x1 = y1; x2 = y2; }
            rp[c1] = (unsigned short)(cvtpk(x1, 0.f) & 0xffffu); rp[c2] = (unsigned short)(cvtpk(x2, 0.f) & 0xffffu);
            if (st_k && !lat && gI >= 16) { float* sp = st_k + (size_t)row * 256 + (gI - 16) * 64 + part * 32 + i; sp[0] = x1; sp[16] = x2; }
        }
    }
}
struct KVSeg { const bf16_t* k; const bf16_t* v; int ldk, ldv, n; };
typedef short v4i16_t __attribute__((ext_vector_type(4)));
__device__ __forceinline__ s16x4 vtr(const LAS unsigned char* p) { return __builtin_bit_cast(s16x4, __builtin_amdgcn_ds_read_tr16_b64_v4i16((LAS v4i16_t*)p)); }
constexpr int AT_BTAB = 65536;
constexpr int AT_PARK = 73728;
__device__ __forceinline__ void glds16(const void* gsrc, unsigned lds_dst) { unsigned keep;
    asm volatile("s_mov_b32 %0, m0\n\ts_mov_b32 m0, %2\n\ts_nop 0\n\tglobal_load_lds_dwordx4 %1, off\n\ts_mov_b32 m0, %0" : "=&s"(keep) : "v"(gsrc), "s"(lds_dst) : "memory"); }

template <int DV, int MODE>
__device__ __forceinline__ void attn_run(LAS unsigned char* lds, const bf16_t* Qw, int ldq, const KVSeg s0, const KVSeg s1,
                                         int krow_lo, int rq, int cq, f32x16 (&o)[DV / 32], float& ltot) {
    constexpr int NS = DV == 128 ? 3 : 4, KBY = 8192, VBY = 64 * DV * 2, SLOT = KBY + VBY, RB = DV * 2;
    const int tid = tid_opaque(), lane = tid & 63, r32 = lane & 31, hi = lane >> 5;
    const int wave = __builtin_amdgcn_readfirstlane(tid >> 6);
    const unsigned lds0 = (unsigned)(uintptr_t)lds;
    const int ntile = (s0.n + s1.n) >> 6;
    const int krow = 8 * wave + (lane >> 3), kchunk = (lane & 7) ^ (lane >> 3);
    auto issue = [&](int t) {
        int kb = t * 64; const bf16_t* kp; const bf16_t* vp; int ldk, ldv;
        if (kb < s0.n) { kp = s0.k; vp = s0.v; ldk = s0.ldk; ldv = s0.ldv; } else { kb -= s0.n; kp = s1.k; vp = s1.v; ldk = s1.ldk; ldv = s1.ldv; }
        const unsigned sl = lds0 + (unsigned)((t % NS) * SLOT);
        glds16(kp + (size_t)(kb + krow) * ldk + kchunk * 8, (unsigned)__builtin_amdgcn_readfirstlane(sl + wave * 1024));
        if (DV == 64) glds16(vp + (size_t)(kb + krow) * ldv + kchunk * 8, (unsigned)__builtin_amdgcn_readfirstlane(sl + KBY + wave * 1024));
        else {
#pragma unroll
            for (int i = 0; i < 2; ++i) { const int piece = 2 * wave + i, vrow = 4 * piece + (lane >> 4), vch = (lane & 15) ^ (vrow & 7);
                glds16(vp + (size_t)(kb + vrow) * ldv + vch * 8, (unsigned)__builtin_amdgcn_readfirstlane(sl + KBY + piece * 1024)); }
        }
    };
    constexpr int IPT = DV == 128 ? 3 : 2;
#define AT_WAITBAR(tn, last) do { if ((last) - (tn) >= NS - 2) { if (IPT * (NS - 2) == 4) asm volatile("s_waitcnt vmcnt(4) lgkmcnt(0)\n\ts_barrier" ::: "memory"); else asm volatile("s_waitcnt vmcnt(3) lgkmcnt(0)\n\ts_barrier" ::: "memory"); } \
        else asm volatile("s_waitcnt vmcnt(0) lgkmcnt(0)\n\ts_barrier" ::: "memory"); } while (0)
    static_assert(IPT * (NS - 2) == 4 || IPT * (NS - 2) == 3, "vmcnt immediates");
    const int npre = ntile < NS - 1 ? ntile : NS - 1;
    for (int t = 0; t < npre; ++t) issue(t);
    bf16x8 qf[4];
#pragma unroll
    for (int ks = 0; ks < 4; ++ks) qf[ks] = *(const bf16x8*)(Qw + (size_t)r32 * ldq + ks * 16 + hi * 8);
#pragma unroll
    for (int b = 0; b < DV / 32; ++b)
#pragma unroll
        for (int r = 0; r < 16; ++r) o[b][r] = 0.f;
    float m_run = -1e30f, lsum = 0.f;
    int koff[4];
#pragma unroll
    for (int ks = 0; ks < 4; ++ks) koff[ks] = r32 * 128 + (((2 * ks + hi) ^ (r32 & 7)) << 4);
    const int q4 = (lane & 15) >> 2, p4 = lane & 3, g1 = (lane >> 4) & 1;
    const int vlane = (4 * hi + q4) * RB + 16 * ((2 * g1 + (p4 >> 1)) ^ q4) + 8 * (p4 & 1);
    const int vb0 = KBY + vlane + 64 * hi, vb1 = KBY + vlane + 64 * (1 - hi);
    const int rs = MODE == 1 ? min(max(rq - 4, 0), 8) : 0, cs = MODE == 1 ? min(max(cq - 8, 0), 48) : 0;
    const LAS float* btab = (const LAS float*)(lds + AT_BTAB);
    const float SC = 0.125f * LOG2E;
    AT_WAITBAR(0, npre - 1);
    for (int t = 0; t < ntile; ++t) {
        if (t + NS - 1 < ntile) issue(t + NS - 1);
        bool active = true; int kr = 0;
        if (MODE == 1 && t >= 4) { kr = krow_lo + t - 4; active = (kr >= rs) && (kr < rs + 8); }
        if (active) {
            const LAS unsigned char* Sl = lds + (t % NS) * SLOT;
            f32x16 p0, p1;
#pragma unroll
            for (int r = 0; r < 16; ++r) { p0[r] = 0.f; p1[r] = 0.f; }
#pragma unroll
            for (int ks = 0; ks < 4; ++ks) {
                const bf16x8 a0 = *(const LAS bf16x8*)(Sl + koff[ks]), a1 = *(const LAS bf16x8*)(Sl + 32 * 128 + koff[ks]);
                p0 = __builtin_amdgcn_mfma_f32_32x32x16_bf16(a0, qf[ks], p0, 0, 0, 0);
                p1 = __builtin_amdgcn_mfma_f32_32x32x16_bf16(a1, qf[ks], p1, 0, 0, 0);
            }
            if (MODE == 1 && t >= 4) {
                const LAS float* brow = btab + (kr - rq + 7) * 31 + 15 - cq;
#pragma unroll
                for (int r = 0; r < 16; ++r) {
                    const int kc0 = crow(r, hi), kc1 = kc0 + 32;
                    const bool v0 = (unsigned)(kc0 - cs) < 16u, v1 = (unsigned)(kc1 - cs) < 16u;
                    const float b0 = v0 ? brow[kc0] : 0.f, b1 = v1 ? brow[kc1] : 0.f;
                    p0[r] = v0 ? (p0[r] + 8.f * b0) : -INFINITY;
                    p1[r] = v1 ? (p1[r] + 8.f * b1) : -INFINITY;
                }
            }
            float mt = fmaxf(p0[0], p1[0]);
#pragma unroll
            for (int r = 1; r < 16; ++r) mt = fmaxf(fmaxf(mt, p0[r]), p1[r]);
            mt = fmaxf(mt, __shfl_xor(mt, 32));
            const float m_new = fmaxf(m_run, mt);
            if (__any(m_new > m_run)) {
                const float alpha = __builtin_amdgcn_exp2f((m_run - m_new) * SC);
                m_run = m_new; lsum *= alpha;
#pragma unroll
                for (int b = 0; b < DV / 32; ++b)
#pragma unroll
                    for (int r = 0; r < 16; ++r) o[b][r] *= alpha;
            }
            const float nmsc = -m_run * SC;
            float ps = 0.f;
#pragma unroll
            for (int r = 0; r < 16; ++r) { p0[r] = __builtin_amdgcn_exp2f(__builtin_fmaf(p0[r], SC, nmsc)); p1[r] = __builtin_amdgcn_exp2f(__builtin_fmaf(p1[r], SC, nmsc)); ps += p0[r] + p1[r]; }
            lsum += ps;
#pragma unroll
            for (int blk = 0; blk < 2; ++blk)
#pragma unroll
                for (int s = 0; s < 2; ++s) {
                    u32x4 pw;
                    if (blk == 0) { pw.x = cvtpk(p0[8 * s + 0], p0[8 * s + 1]); pw.y = cvtpk(p0[8 * s + 2], p0[8 * s + 3]); pw.z = cvtpk(p0[8 * s + 4], p0[8 * s + 5]); pw.w = cvtpk(p0[8 * s + 6], p0[8 * s + 7]); }
                    else          { pw.x = cvtpk(p1[8 * s + 0], p1[8 * s + 1]); pw.y = cvtpk(p1[8 * s + 2], p1[8 * s + 3]); pw.z = cvtpk(p1[8 * s + 4], p1[8 * s + 5]); pw.w = cvtpk(p1[8 * s + 6], p1[8 * s + 7]); }
                    const bf16x8 pb = __builtin_bit_cast(bf16x8, pw);
#pragma unroll
                    for (int dvb = 0; dvb < DV / 32; ++dvb) {
                        const LAS unsigned char* vp_ = Sl + ((dvb & 1) ? vb1 : vb0) + 128 * (dvb >> 1) + (32 * blk + 16 * s) * RB;
                        const s16x4 lo = vtr(vp_), h8 = vtr(vp_ + 8 * RB);
                        const bf16x8 af = {lo[0], lo[1], lo[2], lo[3], h8[0], h8[1], h8[2], h8[3]};
                        o[dvb] = __builtin_amdgcn_mfma_f32_32x32x16_bf16(af, pb, o[dvb], 0, 0, 0);
                    }
                }
        }
        { const int last = (t + NS - 1 < ntile) ? t + NS - 1 : ntile - 1; AT_WAITBAR(t + 1, last); }
    }
#undef AT_WAITBAR
    ltot = lsum + __shfl_xor(lsum, 32);
}

template <int DV>
__device__ __forceinline__ void attn_store(const f32x16 (&o)[DV / 32], bf16_t* Orow  , int hi) {
#pragma unroll
    for (int dvb = 0; dvb < DV / 32; ++dvb)
#pragma unroll
        for (int g4 = 0; g4 < 4; ++g4) { u32x2 w; w.x = cvtpk(o[dvb][4 * g4 + 0], o[dvb][4 * g4 + 1]); w.y = cvtpk(o[dvb][4 * g4 + 2], o[dvb][4 * g4 + 3]);
            *(u32x2*)(Orow + 32 * dvb + 8 * g4 + 4 * hi) = w; }
}

__device__ __forceinline__ void phase_attn_da(const Params& P, LAS unsigned char* lds) {
    const int tid = tid_opaque(), lane = tid & 63, wave = __builtin_amdgcn_readfirstlane(tid >> 6), r32 = lane & 31, hi = lane >> 5;
    const bf16_t* QKV = wsb(P.ws, WS_QKV); bf16_t* AO = wsb(P.ws, WS_AO);
    const bf16_t* CK = wsb(P.ws, WS_CKDA); const bf16_t* CV = wsb(P.ws, WS_CVDA);
    const float* lp = P.in[18];
    const float lam = expf(wave_sum(lp[lane] * lp[64 + lane])) - expf(wave_sum(lp[128 + lane] * lp[192 + lane])) + 0.2f;
    const float* sg = P.in[19];
    for (int u = blockIdx.x; u < 384; u += gridDim.x) {
        int qrow0, h; KVSeg s0, s1;
        if (u < 256) { const int b = u >> 5, qb = u & 3; h = (u >> 2) & 7; qrow0 = RC + b * 1024 + qb * 256;
            s0.k = CK + (size_t)b * 256 * 1024 + h * 128; s0.v = CV + (size_t)b * 256 * 1024 + h * 128; s0.ldk = 1024; s0.ldv = 1024; s0.n = 256;
            const bf16_t* base = QKV + (size_t)(RC + b * 1024) * 3072; s1.k = base + 1024 + h * 128; s1.v = base + 2048 + h * 128; s1.ldk = 3072; s1.ldv = 3072; s1.n = 1024; }
        else { const int uc = u - 256, b = uc >> 3; h = uc & 7; qrow0 = b * 256;
            const bf16_t* base = QKV + (size_t)(b * 256) * 3072; s0.k = base + 1024 + h * 128; s0.v = base + 2048 + h * 128; s0.ldk = 3072; s0.ldv = 3072; s0.n = 256;
            s1 = s0; s1.n = 0; }
        const int qrow = qrow0 + wave * 32;
        const bf16_t* Qw = QKV + (size_t)qrow * 3072 + h * 128;
        f32x16 oa[4]; float la, lb;
        LAS unsigned* park = (LAS unsigned*)(lds + AT_PARK + wave * 8192) + lane;
        attn_run<128, 0>(lds, Qw, 3072, s0, s1, 0, 0, 0, oa, la);
        { const float ia = 1.f / la;
#pragma unroll
          for (int b = 0; b < 4; ++b)
#pragma unroll
              for (int r = 0; r < 16; r += 2) park[(b * 8 + (r >> 1)) * 64] = cvtpk(oa[b][r] * ia, oa[b][r + 1] * ia); }
        KVSeg t0 = s0, t1 = s1; t0.k += 64; t1.k += 64;
        attn_run<128, 0>(lds, Qw + 64, 3072, t0, t1, 0, 0, 0, oa, lb);
        const float ib = lam / lb; float ss = 0.f;
#pragma unroll
        for (int b = 0; b < 4; ++b)
#pragma unroll
            for (int r = 0; r < 16; r += 2) { const unsigned w = park[(b * 8 + (r >> 1)) * 64];
                oa[b][r] = bflo(w) - ib * oa[b][r]; oa[b][r + 1] = bfhi(w) - ib * oa[b][r + 1]; ss += oa[b][r] * oa[b][r] + oa[b][r + 1] * oa[b][r + 1]; }
        ss += __shfl_xor(ss, 32);
        const float rstd = 0.8f / sqrtf(ss * (1.f / 128.f) + 1e-6f);
#pragma unroll
        for (int b = 0; b < 4; ++b)
#pragma unroll
            for (int g4 = 0; g4 < 4; ++g4) { const f32x4 gv = *(const f32x4*)(sg + 32 * b + 8 * g4 + 4 * hi);
#pragma unroll
                for (int i = 0; i < 4; ++i) oa[b][4 * g4 + i] *= rstd * gv[i]; }
        attn_store<128>(oa, AO + (size_t)(qrow + r32) * D + h * 128, hi);
    }
}
__device__ __forceinline__ void phase_attn_na(const Params& P, LAS unsigned char* lds) {
    const int tid = tid_opaque(), lane = tid & 63, wave = __builtin_amdgcn_readfirstlane(tid >> 6), r32 = lane & 31, hi = lane >> 5;
    const bf16_t* QKV = wsb(P.ws, WS_QKV); bf16_t* AO = wsb(P.ws, WS_AO);
    const bf16_t* CK = wsb(P.ws, WS_CKNA); const bf16_t* CV = wsb(P.ws, WS_CVNA);
    for (int u = blockIdx.x; u < 768; u += gridDim.x) {
        f32x16 o[2]; float l; int qrow, h;
        if (u < 512) { const int b = u >> 6, qb = u & 3; h = (u >> 2) & 15; const int r0 = 4 * qb;
            const int klo = min(max(r0 - 4, 0), 8), khi = min(max(r0 - 1, 0), 8) + 7;
            KVSeg s0, s1;
            s0.k = CK + (size_t)b * 256 * 1024 + h * 64; s0.v = CV + (size_t)b * 256 * 1024 + h * 64; s0.ldk = 1024; s0.ldv = 1024; s0.n = 256;
            const bf16_t* base = QKV + (size_t)(RC + b * 1024 + klo * 64) * 3072; s1.k = base + 1024 + h * 64; s1.v = base + 2048 + h * 64; s1.ldk = 3072; s1.ldv = 3072; s1.n = (khi - klo + 1) * 64;
            LAS float* btab = (LAS float*)(lds + AT_BTAB);
            if (tid < 465) btab[tid] = P.in[22][h * 465 + tid];
            qrow = RC + b * 1024 + qb * 256 + wave * 32;
            attn_run<64, 1>(lds, QKV + (size_t)qrow * 3072 + h * 64, 3072, s0, s1, klo, r0 + (wave >> 1), 32 * (wave & 1) + r32, o, l); }
        else { const int uc = u - 512, b = uc >> 4; h = uc & 15;
            const bf16_t* base = QKV + (size_t)(b * 256) * 3072; KVSeg s0, s1; s0.k = base + 1024 + h * 64; s0.v = base + 2048 + h * 64; s0.ldk = 3072; s0.ldv = 3072; s0.n = 256; s1 = s0; s1.n = 0;
            qrow = b * 256 + wave * 32;
            attn_run<64, 0>(lds, QKV + (size_t)qrow * 3072 + h * 64, 3072, s0, s1, 0, 0, 0, o, l); }
        const float il = 1.f / l;
#pragma unroll
        for (int b = 0; b < 2; ++b)
#pragma unroll
            for (int r = 0; r < 16; ++r) o[b][r] *= il;
        attn_store<64>(o, AO + (size_t)(qrow + r32) * D + h * 64, hi);
    }
}
__device__ __forceinline__ void phase_attn_gq(const Params& P, LAS unsigned char* lds) {
    const int tid = tid_opaque(), lane = tid & 63, wave = __builtin_amdgcn_readfirstlane(tid >> 6), r32 = lane & 31, hi = lane >> 5;
    const bf16_t* QKV = wsb(P.ws, WS_QKV); bf16_t* AO = wsb(P.ws, WS_AO);
    const bf16_t* CK = wsb(P.ws, WS_CKGQ); const bf16_t* CV = wsb(P.ws, WS_CVGQ);
    for (int u = blockIdx.x; u < 768; u += gridDim.x) {
        f32x16 o[2]; float l; int qrow, h; KVSeg s0, s1;
        if (u < 512) { const int b = u >> 6, qb = u & 3; h = (u >> 2) & 15; const int kv = h >> 2;
            s0.k = CK + (size_t)b * 256 * 256 + kv * 64; s0.v = CV + (size_t)b * 256 * 256 + kv * 64; s0.ldk = 256; s0.ldv = 256; s0.n = 256;
            const bf16_t* base = QKV + (size_t)(RC + b * 1024) * 1536; s1.k = base + 1024 + kv * 64; s1.v = base + 1280 + kv * 64; s1.ldk = 1536; s1.ldv = 1536; s1.n = 1024;
            qrow = RC + b * 1024 + qb * 256 + wave * 32; }
        else { const int uc = u - 512, b = uc >> 4; h = uc & 15; const int kv = h >> 2;
            const bf16_t* base = QKV + (size_t)(b * 256) * 1536; s0.k = base + 1024 + kv * 64; s0.v = base + 1280 + kv * 64; s0.ldk = 1536; s0.ldv = 1536; s0.n = 256; s1 = s0; s1.n = 0;
            qrow = b * 256 + wave * 32; }
        attn_run<64, 0>(lds, QKV + (size_t)qrow * 1536 + h * 64, 1536, s0, s1, 0, 0, 0, o, l);
        const float il = 1.f / l;
#pragma unroll
        for (int b = 0; b < 2; ++b)
#pragma unroll
            for (int r = 0; r < 16; ++r) o[b][r] *= il;
        attn_store<64>(o, AO + (size_t)(qrow + r32) * D + h * 64, hi);
    }
}
template <int L, int NB>
__device__ __forceinline__ void hyena_unit(const Params& P, LAS unsigned char* lds, int cp, int rowbase) {
    constexpr int ZS = L + 32, CS = 2 * L + 32;
    constexpr int IMG_B = 2 * 4 * CS * 2, Z_B = 2 * NB * ZS * 2;
    constexpr int NTT = L / 16, TPW = NTT / 4, NSS = L / 32;
    LAS unsigned char* img = lds; LAS unsigned char* zb0 = lds + IMG_B; LAS unsigned char* zb1 = lds + IMG_B + Z_B;
    const int tid = tid_opaque(), lane = tid & 63, wave = __builtin_amdgcn_readfirstlane(tid >> 6);
    const bf16_t* UT = wsb(P.ws, WS_QKV); bf16_t* AO = wsb(P.ws, WS_AO);
    const bf16_t* GP = L == 1024 ? wsb(P.ws, WS_GP1) : wsb(P.ws, WS_GP0);
    const float* sw = P.in[28]; const float* sb = P.in[29]; const float* fb = P.in[37];
    for (int task = tid; task < 2 * NB * (L / 8); task += NT) {
        const int t8 = (task % (L / 8)) * 8, b = (task / (L / 8)) % NB, ch = task / ((L / 8) * NB);
        const int d = 2 * cp + ch;
        const bf16_t* up = UT + (size_t)d * R + rowbase + b * L + t8;
        const u32x4 w = *(const u32x4*)up;
        float x[10];
        x[0] = t8 > 0 ? bf2f(up[-1]) : 0.f; x[9] = t8 + 8 < L ? bf2f(up[8]) : 0.f;
        x[1] = bflo(w.x); x[2] = bfhi(w.x); x[3] = bflo(w.y); x[4] = bfhi(w.y); x[5] = bflo(w.z); x[6] = bfhi(w.z); x[7] = bflo(w.w); x[8] = bfhi(w.w);
        const float w0 = sw[d], w1 = sw[3072 + d], w2 = sw[6144 + d], bb = sb[d];
        float y[8];
#pragma unroll
        for (int i = 0; i < 8; ++i) y[i] = x[i] * w0 + x[i + 1] * w1 + x[i + 2] * w2 + bb;
        u32x4 ow; ow.x = cvtpk(y[0], y[1]); ow.y = cvtpk(y[2], y[3]); ow.z = cvtpk(y[4], y[5]); ow.w = cvtpk(y[6], y[7]);
        *(LAS u32x4*)(zb0 + ((ch * NB + b) * ZS + t8) * 2) = ow;
    }
    const int ch = wave >> 2, w4 = wave & 3, d = 2 * cp + ch;
    const int bcol = lane & 15, q = lane >> 4;
#pragma unroll 1
    for (int o = 0; o < 2; ++o) {
        for (int task = tid; task < 2 * (2 * L / 4 + 1); task += NT) {
            const int i = task % (2 * L / 4 + 1), c2 = task / (2 * L / 4 + 1);
            const unsigned long long* gp = (const unsigned long long*)(GP + ((size_t)(o * 1024 + 2 * cp + c2)) * (2 * L));
            const unsigned long long wp = i > 0 ? gp[i - 1] : 0ull, wc = i < 2 * L / 4 ? gp[i] : 0ull;
            LAS unsigned char* ib = img + (c2 * 4) * CS * 2 + i * 8;
            *(LAS unsigned long long*)(ib) = wc;
            *(LAS unsigned long long*)(ib + 1 * CS * 2) = (wp >> 48) | (wc << 16);
            *(LAS unsigned long long*)(ib + 2 * CS * 2) = (wp >> 32) | (wc << 32);
            *(LAS unsigned long long*)(ib + 3 * CS * 2) = (wp >> 16) | (wc << 48);
        }
        __syncthreads();
        const LAS unsigned char* zsrc = (o == 0 ? zb0 : zb1) + (ch * NB) * ZS * 2;
        constexpr int TH = TPW > 8 ? 8 : TPW, NPASS = TPW / TH;
        const int r = lane & 15, c = r & 3;
        const LAS unsigned char* abase = img + ((ch * 4 + c) * CS + (L - r + 8 * q + c)) * 2;
        const int colp = (o + 1) * 1024 + d;
        const float gw0 = sw[colp], gw1 = sw[3072 + colp], gw2 = sw[6144 + colp], gbb = sb[colp], fbo = fb[o * 1024 + d];
        const bf16_t* up0 = UT + (size_t)colp * R + rowbase + (bcol < NB ? bcol : 0) * L;
#pragma unroll 1
        for (int pass = 0; pass < NPASS; ++pass) {
            f32x4 acc[TH];
#pragma unroll
            for (int k = 0; k < TH; ++k) acc[k] = (f32x4){0.f, 0.f, 0.f, 0.f};
            const int tile0 = w4 * TPW + pass * TH;
            bf16x8 aw[TH];
            const LAS unsigned char* ab2 = abase - 32 * tile0;
#define HY_LDA(slot, e) do { const LAS unsigned char* ap_ = ab2 - 32 * (e); const s16x4 lo_ = *(const LAS s16x4*)ap_, hi_ = *(const LAS s16x4*)(ap_ + 8); \
                aw[slot] = (bf16x8){lo_[0], lo_[1], lo_[2], lo_[3], hi_[0], hi_[1], hi_[2], hi_[3]}; } while (0)
#pragma unroll
            for (int k = 0; k < TH; ++k) HY_LDA(k, k);
#pragma unroll 1
            for (int ssb = 0; ssb < NSS; ssb += TH / 2) {
#pragma unroll
                for (int u = 0; u < TH / 2; ++u) {
                    const int ss = ssb + u;
                    bf16x8 bfr = {0, 0, 0, 0, 0, 0, 0, 0};
                    if (bcol < NB) bfr = *(const LAS bf16x8*)(zsrc + (bcol * ZS + 32 * ss + 8 * q) * 2);
#pragma unroll
                    for (int k = 0; k < TH; ++k) acc[k] = __builtin_amdgcn_mfma_f32_16x16x32_bf16(aw[(k - 2 * u + 2 * TH) % TH], bfr, acc[k], 0, 0, 0);
                    if (ss + 1 < NSS) { HY_LDA((TH - 2 - 2 * u + 2 * TH) % TH, -2 * (ss + 1)); HY_LDA((TH - 1 - 2 * u + 2 * TH) % TH, 1 - 2 * (ss + 1)); }
                }
            }
#undef HY_LDA
            if (bcol < NB) {
#pragma unroll 2
                for (int k = 0; k < TH; ++k) {
                    const int t4 = 16 * (tile0 + k) + 4 * q;
                    const bf16_t* up = up0 + t4;
                    const u32x2 w = *(const u32x2*)up;
                    float x[6];
                    x[0] = t4 > 0 ? bf2f(up[-1]) : 0.f; x[5] = t4 + 4 < L ? bf2f(up[4]) : 0.f;
                    x[1] = bflo(w.x); x[2] = bfhi(w.x); x[3] = bflo(w.y); x[4] = bfhi(w.y);
                    const u32x2 zw = *(const LAS u32x2*)(zsrc + (bcol * ZS + t4) * 2);
                    float zv[4] = {bflo(zw.x), bfhi(zw.x), bflo(zw.y), bfhi(zw.y)};
                    float val[4];
#pragma unroll
                    for (int j = 0; j < 4; ++j) { const float pv = x[j] * gw0 + x[j + 1] * gw1 + x[j + 2] * gw2 + gbb; val[j] = pv * (acc[k][j] + zv[j] * fbo); }
                    if (o == 0) { u32x2 ow; ow.x = cvtpk(val[0], val[1]); ow.y = cvtpk(val[2], val[3]); *(LAS u32x2*)(zb1 + ((ch * NB + bcol) * ZS + t4) * 2) = ow; }
                    else {
                        bf16_t* op = AO + (size_t)(rowbase + bcol * L + t4) * D + d;
#pragma unroll
                        for (int j = 0; j < 4; ++j) op[(size_t)j * D] = (unsigned short)(cvtpk(val[j], 0.f) & 0xffffu);
                    }
                }
            }
        }
        __syncthreads();
    }
}
__device__ __forceinline__ void phase_hyena(const Params& P, LAS unsigned char* lds) {
    for (int u = blockIdx.x; u < 1024; u += gridDim.x) {
        if (u < 512) hyena_unit<1024, 8>(P, lds, u, RC);
        else hyena_unit<256, 16>(P, lds, u - 512, 0);
    }
}
#define XB_TMO      128
#define XB_XCNT(j)  (256  + 64 * (j))
#define XB_XSUB(j)  (1280 + 64 * (j))
#define XB_XGEN(j)  (2304 + 64 * (j))
#define XB_TOP      3328
#define XB_TOPGEN   3392
#define XCD_BAR_WORDS 3456
#define XB_SPIN_CAP (1u << 18)

__device__ __forceinline__ unsigned xb_ld(unsigned* p)              { return __hip_atomic_load(p, __ATOMIC_RELAXED, __HIP_MEMORY_SCOPE_AGENT); }
__device__ __forceinline__ unsigned xb_add(unsigned* p, unsigned v) { return __hip_atomic_fetch_add(p, v, __ATOMIC_RELAXED, __HIP_MEMORY_SCOPE_AGENT); }
__device__ __forceinline__ unsigned xb_xcc_id() { return (unsigned)__builtin_amdgcn_s_getreg((3 << 11) | 20) & 0xFu; }
#define XB_SPIN(cond, bar) do { unsigned _sp = 0; while (cond) { __builtin_amdgcn_s_sleep(1); \
    if ((++_sp & 255u) == 0u) { if (xb_ld(&(bar)[XB_TMO])) break; if (_sp > XB_SPIN_CAP) { atomicAdd(&(bar)[XB_TMO], 1u); break; } } } } while (0)

struct XcdBarrier {
    unsigned* bar; unsigned x;
    volatile LAS unsigned* st;
};

__device__ __forceinline__ XcdBarrier xcd_barrier_post(unsigned* bar, volatile LAS unsigned* st) {
    XcdBarrier b; b.bar = bar; b.x = xb_xcc_id(); b.st = st;
    if (threadIdx.x == 0) (void)xb_add(&bar[XB_XCNT(b.x)], 1u);
    return b;
}
__device__ __forceinline__ void xcd_barrier_complete(unsigned* bar, unsigned x, unsigned& nloc, unsigned& nx) {
    const unsigned G = gridDim.x * gridDim.y * gridDim.z;
    unsigned sum, cnt, mine, sp = 0u;
    for (;;) {
        sum = 0u; cnt = 0u; mine = 0u;
#pragma unroll
        for (unsigned j = 0; j < 16; ++j) { const unsigned c = xb_ld(&bar[XB_XCNT(j)]); sum += c; cnt += (c > 0u) ? 1u : 0u; mine = (j == x) ? c : mine; }
        if (sum == G) break;
        __builtin_amdgcn_s_sleep(1);
        if ((++sp & 255u) == 0u) { if (xb_ld(&bar[XB_TMO])) break; if (sp > XB_SPIN_CAP) { atomicAdd(&bar[XB_TMO], 1u); break; } }
    }
    nloc = mine > 0u ? mine : 1u; nx = cnt > 0u ? cnt : 1u;
}

__device__ __forceinline__ void xcd_barrier(const XcdBarrier& b) {
    asm volatile("s_waitcnt vmcnt(0)" ::: "memory");
    __syncthreads();
    if (threadIdx.x == 0) {
        unsigned* bar = b.bar;
        __builtin_amdgcn_s_waitcnt(0);
        unsigned nloc = b.st[0], nx = b.st[1];
        if (nloc == 0u) { xcd_barrier_complete(bar, b.x, nloc, nx); b.st[0] = nloc; b.st[1] = nx; }
        const unsigned old = xb_add(&bar[XB_XSUB(b.x)], 1u);
        const unsigned gen = old / nloc;
        if (old + 1u == (gen + 1u) * nloc) {
            __builtin_amdgcn_fence(__ATOMIC_RELEASE, "agent");
            asm volatile("s_waitcnt vmcnt(0)" ::: "memory");
            const unsigned og = xb_add(&bar[XB_TOP], 1u);
            const unsigned tg = og / nx;
            if (og + 1u == (tg + 1u) * nx) xb_add(&bar[XB_TOPGEN], 1u);
            else XB_SPIN(xb_ld(&bar[XB_TOPGEN]) == tg, bar);
            __builtin_amdgcn_fence(__ATOMIC_ACQUIRE, "agent");
            xb_add(&bar[XB_XGEN(b.x)], 1u);
            asm volatile("s_waitcnt vmcnt(0)" ::: "memory");
        } else {
            XB_SPIN(xb_ld(&bar[XB_XGEN(b.x)]) == gen, bar);
            __builtin_amdgcn_fence(__ATOMIC_ACQUIRE, "agent");
            asm volatile("s_waitcnt vmcnt(0)" ::: "memory");
        }
    }
    __syncthreads();
}

constexpr int N_PHASES = 34;
#ifndef REP_SYNC
#define REP_SYNC 1
#endif
#ifndef REP_PRO
#define REP_PRO 1
#endif
#ifndef REP_MIX
#define REP_MIX 1
#endif
#ifndef REP_LMASK
#define REP_LMASK 0xf
#endif
#ifndef REP_GEMM
#define REP_GEMM 1
#endif
#ifndef EN_MASK
#define EN_MASK 0xfff
#endif
#define EN(b) ((EN_MASK >> (b)) & 1)
__host__ __device__ __forceinline__ bool phase_empty(int ph) { if (ph < 2) return false; const int l = (ph - 2) >> 3, s = (ph - 2) & 7; return s == 1 && (l == 1 || l == 3); }

__global__ void __launch_bounds__(NT, 2) trunk_fwd(Params P) {
    extern __shared__ __attribute__((aligned(16))) unsigned char lds_raw[];
    LAS unsigned char* lds = (LAS unsigned char*)lds_raw;
    cg::grid_group grid = cg::this_grid();
    unsigned char* ws = P.ws;
    float* mod = (float*)(ws + WS_MOD * MiB);
    bf16_t* H = wsb(ws, WS_H); bf16_t* QKV = wsb(ws, WS_QKV); bf16_t* AO = wsb(ws, WS_AO); bf16_t* FF = wsb(ws, WS_FF);
    const int G = gridDim.x, bid = blockIdx.x;
    volatile LAS unsigned* bst = (volatile LAS unsigned*)(lds + LDS_BYTES - 64);
    if (threadIdx.x < 2) bst[threadIdx.x] = 0u;
    __syncthreads();
    XcdBarrier bar = xcd_barrier_post((unsigned*)(ws + WS_CTL * MiB), bst);
    for (int ph = P.ph_lo; ph < P.ph_hi; ++ph) {
        if (phase_empty(ph)) continue;
        if (ph == 0) { for (int rep = 0; rep < REP_PRO; ++rep) { if (EN(0)) prologue(P, lds); if (rep + 1 < REP_PRO) __syncthreads(); } }
        else if (ph == 1) row_pass(P, 0, nullptr, nullptr, mod, 0, 1024);
        else {
            const int l = (ph - 2) >> 3, s = (ph - 2) & 7;
            const float* modl = mod + (size_t)l * 9 * 6144;
            if (s == 0) {
                if (l == 3) {
                    pg8::Gemm g{wsb(ws, WS_WQKV3), H, 3072, R, 1024}; pg8::StaticOrder S; S.init(3072, R, G, bid);
                    EpiQKV E{QKV, R, nullptr, nullptr, 0, 0, 0};
                    for (int rep = 0; rep < REP_GEMM; ++rep) { if (EN(2)) pg8::gemm_phase<EpiQKV, pg8::StaticOrder, true, true>(lds, g, S, E); }
                } else {
                    const int N = l == 2 ? 1536 : 3072;
                    const bf16_t* W = l == 0 ? wsb(ws, WS_WQKV0) : (l == 1 ? wsb(ws, WS_WQKV1) : wsb(ws, WS_WQKV2));
                    pg8::Gemm g{H, W, R, N, 1024}; pg8::StaticOrder S; S.init(R, N, G, bid);
                    EpiQKV E;
                    E.O = QKV; E.ldc = N;
                    if (l == 0) { E.st_k = P.out + OUT_DAK; E.st_v = P.out + OUT_DAV; E.kt0 = 4; E.vt0 = 8; E.st_ld = 1024; }
                    else if (l == 1) { E.st_k = P.out + OUT_NAK; E.st_v = P.out + OUT_NAV; E.kt0 = 4; E.vt0 = 8; E.st_ld = 1024; }
                    else { E.st_k = nullptr; E.st_v = P.out + OUT_GQV; E.kt0 = 4; E.vt0 = 5; E.st_ld = 256; }
                    for (int rep = 0; rep < REP_GEMM; ++rep) { if (EN(2)) pg8::gemm_phase<EpiQKV, pg8::StaticOrder, true, true>(lds, g, S, E); }
                }
            } else if (s == 1) {
                if (l == 0) qkfix(P, QKV, 3072, 32, nullptr, nullptr, nullptr, RC);
                else qkfix(P, QKV, 1536, 20, P.in[25], P.in[26], P.out + OUT_GQK, 0);
            } else if (s == 2) {
              for (int rep = 0; rep < (((REP_LMASK >> l) & 1) ? REP_MIX : 1); ++rep) {
                if (rep) __syncthreads();
                if (l == 0) { if (EN(3)) phase_attn_da(P, lds); }
                else if (l == 1) { if (EN(4)) phase_attn_na(P, lds); }
                else if (l == 2) { if (EN(5)) phase_attn_gq(P, lds); }
                else { if (EN(6)) phase_hyena(P, lds); }
              }
            } else if (s == 3) {
                pg8::Gemm g{AO, wsb(ws, WS_WO + 2 * l), R, 1024, 1024}; pg8::StaticOrder S; S.init(R, 1024, G, bid);
                EpiRes E{P.out, modl + 2048};
                if (EN(7)) pg8::gemm_phase<EpiRes, pg8::StaticOrder, true, true>(lds, g, S, E);
            } else if (s == 4) {
                row_pass(P, 1, P.in[12] + (size_t)(l * 2) * 1024, P.in[13] + (size_t)(l * 2) * 1024, modl, 3072, 4096);
            } else if (s == 5) {
                pg8::Gemm g{H, wsb(ws, WS_W1 + 8 * l), R, FFD, 1024}; pg8::StaticOrder S; S.init(R, FFD, G, bid);
                EpiRelu2 E{FF, FFD};
                for (int rep = 0; rep < REP_GEMM; ++rep) { if (EN(8)) pg8::gemm_phase<EpiRelu2, pg8::StaticOrder, true, true>(lds, g, S, E); }
            } else if (s == 6) {
                pg8::Gemm g{FF, wsb(ws, WS_W2 + 8 * l), R, 1024, FFD}; pg8::StaticOrder S; S.init(R, 1024, G, bid);
                EpiRes E{P.out, modl + 5120};
                if (l < 3 && bid >= 192) { const int t_ = tid_opaque(); transpose_layer(P, l + 1, (LAS float*)(lds + (t_ >> 6) * 8448), (bid - 192) * 8 + (t_ >> 6), (G - 192) * 8, t_ & 63); }
                if (EN(7)) pg8::gemm_phase<EpiRes, pg8::StaticOrder, true, true>(lds, g, S, E);
            } else {
                row_pass(P, 1, P.in[12] + (size_t)(l * 2 + 1) * 1024, P.in[13] + (size_t)(l * 2 + 1) * 1024, l < 3 ? modl + 9 * 6144 : nullptr, 0, 1024);
            }
        }
        if (ph + 1 < P.ph_hi) { for (int rep = 0; rep < REP_SYNC; ++rep) { if (ph == 0) grid.sync(); else xcd_barrier(bar); } }
    }
}

#ifndef MK_MULTI
#define MK_MULTI 0
#endif
extern "C" void kernel_launch(void* const* d_in, const int* in_sizes, int n_in, void* d_out, int out_size, void* d_ws, size_t ws_size, hipStream_t stream) {
    static int grid = 0;
    if (grid == 0) {
        if (n_in != 39 || out_size != (int)OUT_END || ws_size < WS_END * MiB) { fprintf(stderr, "kernel_launch: unexpected shapes (n_in %d out %d ws %zu)\n", n_in, out_size, ws_size); grid = -1; return; }
        int dev = 0, cus = 0, per_cu = 0;
        hipGetDevice(&dev); hipDeviceGetAttribute(&cus, hipDeviceAttributeMultiprocessorCount, dev);
        if (hipFuncSetAttribute((const void*)trunk_fwd, hipFuncAttributeMaxDynamicSharedMemorySize, LDS_BYTES) != hipSuccess) { fprintf(stderr, "kernel_launch: hipFuncSetAttribute failed\n"); grid = -1; return; }
        if (hipOccupancyMaxActiveBlocksPerMultiprocessor(&per_cu, (const void*)trunk_fwd, NT, LDS_BYTES) != hipSuccess || per_cu < 1) { fprintf(stderr, "kernel_launch: occupancy query says %d\n", per_cu); per_cu = 1; }
        (void)hipGetLastError();
        grid = cus * 1;
    }
    if (grid < 0) return;
    if (hipMemsetAsync((char*)d_ws + WS_CTL * MiB, 0, 16384, stream) != hipSuccess) { fprintf(stderr, "kernel_launch: memset failed\n"); return; }
    Params p{};
    for (int i = 0; i < 39; ++i) p.in[i] = (const float*)d_in[i];
    p.out = (float*)d_out; p.ws = (unsigned char*)d_ws;
#if MK_MULTI
    for (int ph = 0; ph < N_PHASES; ++ph) { if (phase_empty(ph)) continue; p.ph_lo = ph; p.ph_hi = ph + 1; hipLaunchKernelGGL(trunk_fwd, dim3(grid), dim3(NT), LDS_BYTES, stream, p); }
#else
    p.ph_lo = 0; p.ph_hi = N_PHASES;
    void* args[] = {&p};
    hipError_t e = hipLaunchCooperativeKernel((const void*)trunk_fwd, dim3(grid), dim3(NT), args, LDS_BYTES, stream);
    if (e != hipSuccess) fprintf(stderr, "cooperative launch failed: %s (grid %d)\n", hipGetErrorString(e), grid);
#endif
}
```
